# Optimizing an MI355X kernel written in HIP

```python
import jax, jax.numpy as jnp
from jax import lax
import numpy as np

D_MODEL = 2048
BATCH = 2
SEQ = 8192
DEPTH = 1

D_MIX = D_MODEL
ATTN_WIDTH = D_MIX // 2
LRU_WIDTH = D_MIX - ATTN_WIDTH
ATTN_HEAD_DIM = 128
ATTN_HEADS = ATTN_WIDTH // ATTN_HEAD_DIM
LRU_BLOCKS = 8
LRU_BLOCK_W = LRU_WIDTH // LRU_BLOCKS
CONV_W = 4
LRU_C = 8.0
Q_BLOCK = 128
NORM_EPS = 1e-6
N_IN = 3 * ATTN_WIDTH + ATTN_HEADS + ATTN_WIDTH + LRU_WIDTH + LRU_WIDTH
SPLITS = (ATTN_WIDTH, 2 * ATTN_WIDTH, 3 * ATTN_WIDTH, 3 * ATTN_WIDTH + ATTN_HEADS,
          4 * ATTN_WIDTH + ATTN_HEADS, 4 * ATTN_WIDTH + ATTN_HEADS + LRU_WIDTH)

kernel_name = "hymba_fox_rglru_parallel_heads"


def _rmsnorm(x, g):
    x32 = x.astype(jnp.float32)
    y = x32 * lax.rsqrt(jnp.mean(x32 * x32, axis=-1, keepdims=True) + NORM_EPS)
    return (y * g.astype(jnp.float32)).astype(x.dtype)


def _forgetting_attention(q, k, v, log_f):
    B, S, H, Dh = q.shape
    qh = q.transpose(0, 2, 1, 3)
    kh = k.transpose(0, 2, 1, 3)
    vh = v.transpose(0, 2, 1, 3)
    c = jnp.cumsum(log_f, axis=1).transpose(0, 2, 1)
    kpos = jnp.arange(S)
    scale = ATTN_HEAD_DIM ** -0.5
    n_blocks = S // Q_BLOCK

    def block(i):
        start = i * Q_BLOCK
        qb = lax.dynamic_slice_in_dim(qh, start, Q_BLOCK, axis=2)
        cq = lax.dynamic_slice_in_dim(c, start, Q_BLOCK, axis=2)
        s = jnp.einsum('bhqd,bhkd->bhqk', qb, kh,
                       preferred_element_type=jnp.float32) * scale
        s = s + cq[..., :, None] - c[..., None, :]
        qpos = start + jnp.arange(Q_BLOCK)
        s = jnp.where(kpos[None, :] <= qpos[:, None], s, -jnp.inf)
        p = jax.nn.softmax(s, axis=-1)
        return jnp.einsum('bhqk,bhkd->bhqd', p.astype(vh.dtype), vh)

    out = lax.map(block, jnp.arange(n_blocks))
    return out.transpose(1, 0, 3, 2, 4).reshape(B, S, H * Dh)


def _causal_depthwise_conv(x, w, b):
    y = lax.conv_general_dilated(
        x, w[:, None, :].astype(x.dtype), window_strides=(1,),
        padding=[(CONV_W - 1, 0)], dimension_numbers=('NWC', 'WIO', 'NWC'),
        feature_group_count=x.shape[-1])
    return y + b.astype(x.dtype)


def _rg_lru(x, w_r, b_r, w_i, b_i, lam):
    B, S, C = x.shape
    xb = x.reshape(B, S, LRU_BLOCKS, LRU_BLOCK_W)
    r = jax.nn.sigmoid((jnp.einsum('bsnc,ncd->bsnd', xb, w_r).reshape(B, S, C) + b_r).astype(jnp.float32))
    i = jax.nn.sigmoid((jnp.einsum('bsnc,ncd->bsnd', xb, w_i).reshape(B, S, C) + b_i).astype(jnp.float32))
    log_a = -LRU_C * r * jax.nn.softplus(-lam.astype(jnp.float32))
    a = jnp.exp(log_a)
    mult = jnp.sqrt(-jnp.expm1(2.0 * log_a))
    u = mult * i * x.astype(jnp.float32)

    def combine(left, right):
        a1, b1 = left
        a2, b2 = right
        return a1 * a2, a2 * b1 + b2

    _, h = lax.associative_scan(combine, (a, u), axis=1)
    return h.astype(x.dtype)


def setup_inputs(seed: int = 0) -> dict:
    key = jax.random.key(seed)
    ks = jax.random.split(key, 16)
    f32 = jnp.float32
    x = jax.random.normal(ks[0], (BATCH, SEQ, D_MODEL), f32)
    norm_g = 1.0 + 0.01 * jax.random.normal(ks[1], (DEPTH, D_MODEL), f32)
    w_in = jax.random.normal(ks[2], (DEPTH, D_MODEL, N_IN), f32) * D_MODEL ** -0.5
    b_f = 2.0 + 0.5 * jax.random.normal(ks[3], (DEPTH, ATTN_HEADS), f32)
    conv_w = jax.random.normal(ks[4], (DEPTH, CONV_W, LRU_WIDTH), f32) * CONV_W ** -0.5
    conv_b = 0.01 * jax.random.normal(ks[5], (DEPTH, LRU_WIDTH), f32)
    w_rg = jax.random.normal(ks[6], (DEPTH, LRU_BLOCKS, LRU_BLOCK_W, LRU_BLOCK_W), f32) * LRU_BLOCK_W ** -0.5
    b_rg = 0.01 * jax.random.normal(ks[7], (DEPTH, LRU_WIDTH), f32)
    w_ig = jax.random.normal(ks[8], (DEPTH, LRU_BLOCKS, LRU_BLOCK_W, LRU_BLOCK_W), f32) * LRU_BLOCK_W ** -0.5
    b_ig = 0.01 * jax.random.normal(ks[9], (DEPTH, LRU_WIDTH), f32)
    a0 = jax.random.uniform(ks[10], (DEPTH, LRU_WIDTH), f32, minval=0.9, maxval=0.999)
    lru_lambda = jnp.log(a0) - jnp.log1p(-a0)
    attn_norm_g = 1.0 + 0.01 * jax.random.normal(ks[11], (DEPTH, ATTN_WIDTH), f32)
    lru_norm_g = 1.0 + 0.01 * jax.random.normal(ks[12], (DEPTH, LRU_WIDTH), f32)
    w_out = jax.random.normal(ks[13], (DEPTH, D_MIX, D_MODEL), f32) * D_MIX ** -0.5
    final_norm_g = 1.0 + 0.01 * jax.random.normal(ks[14], (D_MODEL,), f32)
    return {"x": x, "norm_g": norm_g, "w_in": w_in, "b_f": b_f, "conv_w": conv_w,
            "conv_b": conv_b, "w_rg": w_rg, "b_rg": b_rg, "w_ig": w_ig, "b_ig": b_ig,
            "lru_lambda": lru_lambda, "attn_norm_g": attn_norm_g, "lru_norm_g": lru_norm_g,
            "w_out": w_out, "final_norm_g": final_norm_g}


def reference(x, norm_g, w_in, b_f, conv_w, conv_b, w_rg, b_rg, w_ig, b_ig,
              lru_lambda, attn_norm_g, lru_norm_g, w_out, final_norm_g):
    B, S, _ = x.shape
    for l in range(DEPTH):
        h = _rmsnorm(x, norm_g[l])
        proj = jnp.einsum('bsd,dn->bsn', h, w_in[l])
        q, k, v, f_logit, z_attn, x_lru, z_lru = jnp.split(proj, SPLITS, axis=-1)
        log_f = jax.nn.log_sigmoid((f_logit + b_f[l]).astype(jnp.float32))
        attn = _forgetting_attention(q.reshape(B, S, ATTN_HEADS, ATTN_HEAD_DIM),
                                     k.reshape(B, S, ATTN_HEADS, ATTN_HEAD_DIM),
                                     v.reshape(B, S, ATTN_HEADS, ATTN_HEAD_DIM), log_f)
        attn = _rmsnorm(attn, attn_norm_g[l]) * jax.nn.silu(z_attn)
        u = _causal_depthwise_conv(x_lru, conv_w[l], conv_b[l])
        lru = _rg_lru(u, w_rg[l], b_rg[l], w_ig[l], b_ig[l], lru_lambda[l])
        lru = _rmsnorm(lru, lru_norm_g[l]) * jax.nn.silu(z_lru)
        mixed = jnp.concatenate([attn, lru], axis=-1)
        x = x + jnp.einsum('bsm,md->bsd', mixed, w_out[l])
    return _rmsnorm(x, final_norm_g)
```

```cpp
#include <hip/hip_runtime.h>
#include <hip/hip_bf16.h>
#include <hip/hip_cooperative_groups.h>
#include <cstdio>
#include <cstdint>
namespace cg = cooperative_groups;

typedef unsigned short u16;
typedef short bf16x8 __attribute__((ext_vector_type(8)));
typedef float f32x4 __attribute__((ext_vector_type(4)));
typedef float f32x16 __attribute__((ext_vector_type(16)));
typedef unsigned u32x4 __attribute__((ext_vector_type(4)));
typedef unsigned u32x2 __attribute__((ext_vector_type(2)));
typedef __bf16 bf2_t __attribute__((ext_vector_type(2)));
typedef float f2_t __attribute__((ext_vector_type(2)));

#ifndef SINGLE_LAUNCH
#define SINGLE_LAUNCH 1
#endif

constexpr int NB = 2, SEQ = 8192, DM = 2048, MTOK = NB * SEQ, NH = 8, HD = 128, AW = 1024, LW = 1024;
constexpr int NIN = 6152, NP = 6144, KD = 2048;
constexpr int NTHR = 512;
constexpr float EPS = 1e-6f;
constexpr float LOG2E = 1.4426950408889634f;
constexpr float QSCALE = 0.08838834764831845f * 1.4426950408889634f;
constexpr int CHUNK = 64, NCHUNK = SEQ / CHUNK;

struct Params {
  const float *x, *norm_g, *w_in, *b_f, *conv_w, *conv_b, *w_rg, *b_rg, *w_ig, *b_ig, *lam, *ag, *lg, *w_out, *fg;
  float* out;
  u16 *hb, *WinT, *WoutT, *WgT, *qb, *kb, *vT, *za, *xl, *zl, *mixed;
  float *logf, *c2, *ssq, *lruA, *lruH;
  unsigned* bar;
};

extern __shared__ __attribute__((aligned(16))) char smem[];

__device__ __forceinline__ unsigned cvtpk(float lo, float hi) {
  f2_t v = {lo, hi}; bf2_t r = __builtin_convertvector(v, bf2_t); return __builtin_bit_cast(unsigned, r);
}
__device__ __forceinline__ float bflo(unsigned u) { return __uint_as_float(u << 16); }
__device__ __forceinline__ float bfhi(unsigned u) { return __uint_as_float(u & 0xffff0000u); }
__device__ __forceinline__ float wsum(float v) {
#pragma unroll
  for (int o = 32; o; o >>= 1) v += __shfl_xor(v, o);
  return v;
}
__device__ __forceinline__ float xh_max(float v) {
  auto rr = __builtin_amdgcn_permlane32_swap(__float_as_uint(v), __float_as_uint(v), false, false);
  return fmaxf(__uint_as_float(rr[0]), __uint_as_float(rr[1]));
}
__device__ __forceinline__ float xh_sum(float v) {
  auto rr = __builtin_amdgcn_permlane32_swap(__float_as_uint(v), __float_as_uint(v), false, false);
  return __uint_as_float(rr[0]) + __uint_as_float(rr[1]);
}
__device__ __forceinline__ float frcp_(float x) { return __builtin_amdgcn_rcpf(x); }
__device__ __forceinline__ float fexp_(float x) { return __builtin_amdgcn_exp2f(x * LOG2E); }
__device__ __forceinline__ float sigmoidf_(float x) { return frcp_(1.f + fexp_(-x)); }
__device__ __forceinline__ float siluf_(float x) { return x * frcp_(1.f + fexp_(-x)); }
__device__ __forceinline__ float log_sigmoidf_(float x) { return fminf(x, 0.f) - log1pf(__expf(-fabsf(x))); }

struct TrDesc { const float* src; u16* dst; const float* ksc; int ld_src, ld_dst; };
__device__ __forceinline__ TrDesc tr_desc(const Params& p, int t) {
  TrDesc d;
  if (t < 3072) {
    const int kt = t & 31, nt = t >> 5, n0 = nt * 64;
    const int sc0 = n0 + (n0 >= 3072 ? 8 : 0);
    d.src = p.w_in + (long)kt * 64 * NIN + sc0; d.ld_src = NIN; d.dst = p.WinT + (long)n0 * KD + kt * 64; d.ld_dst = KD; d.ksc = nullptr;
  } else if (t < 4096) {
    const int u = t - 3072, kt = u & 31, nt = u >> 5;
    d.ksc = (kt < 16) ? (p.ag + kt * 64) : (p.lg + (kt - 16) * 64);
    d.src = p.w_out + (long)kt * 64 * DM + nt * 64; d.ld_src = DM; d.dst = p.WoutT + (long)nt * 64 * KD + kt * 64; d.ld_dst = KD;
  } else {
    const int u = t - 4096, mat = u >> 2, sub = u & 3, kt = sub & 1, nt = sub >> 1;
    const float* sm = (mat < 8) ? (p.w_rg + mat * 16384) : (p.w_ig + (mat - 8) * 16384);
    d.src = sm + kt * 64 * 128 + nt * 64; d.ld_src = 128; d.dst = p.WgT + mat * 16384 + nt * 64 * 128 + kt * 64; d.ld_dst = 128; d.ksc = nullptr;
  }
  return d;
}

__device__ void phase_prep(const Params& p) {
  int tid = threadIdx.x; asm volatile("" : "+v"(tid));
  const int lane = tid & 63, wid = tid >> 6;
  for (int i = blockIdx.x * NTHR + tid; i < 3 * MTOK + 16 + 64; i += gridDim.x * NTHR) p.ssq[i] = 0.f;
  {
    constexpr int NT = 3072 + 1024 + 64;
    float* T = (float*)smem + wid * (64 * 65);
    const int r4 = lane >> 4, c4 = (lane & 15) * 4;
    const int n8 = lane >> 3, k8 = (lane & 7) * 8;
    for (int t = blockIdx.x * 8 + wid; t < NT; t += 8 * gridDim.x) {
      const TrDesc d = tr_desc(p, t);
      f32x4 v[16]; float sc[16];
#pragma unroll
      for (int i = 0; i < 16; ++i) {
        const int rr = i * 4 + r4;
        v[i] = __builtin_nontemporal_load((const f32x4*)(d.src + (long)rr * d.ld_src + c4));
        sc[i] = d.ksc ? d.ksc[rr] : 1.f;
      }
#pragma unroll
      for (int i = 0; i < 16; ++i) {
        const int rr = i * 4 + r4;
        T[rr * 65 + c4 + 0] = v[i][0] * sc[i]; T[rr * 65 + c4 + 1] = v[i][1] * sc[i];
        T[rr * 65 + c4 + 2] = v[i][2] * sc[i]; T[rr * 65 + c4 + 3] = v[i][3] * sc[i];
      }
#pragma unroll
      for (int j = 0; j < 8; ++j) {
        const int n = n8 + 8 * j;
        float tt[8];
#pragma unroll
        for (int i = 0; i < 8; ++i) tt[i] = T[(k8 + i) * 65 + n];
        u32x4 pk = {cvtpk(tt[0], tt[1]), cvtpk(tt[2], tt[3]), cvtpk(tt[4], tt[5]), cvtpk(tt[6], tt[7])};
        *(u32x4*)(d.dst + (long)n * d.ld_dst + k8) = pk;
      }
    }
  }
  __syncthreads();
  f32x4* WF = (f32x4*)smem;
  for (int idx = tid; idx < 4096; idx += NTHR) {
    const int ln = idx & 63, half = (idx >> 6) & 1, e = (idx >> 7) & 3, i = idx >> 9;
    const int k = (i * 64 + ln) * 4 + e;
    WF[idx] = *(const f32x4*)(p.w_in + (long)k * NIN + 3072 + half * 4);
  }
  __syncthreads();
  f32x4 xn[8];
  {
    const f32x4* xr = (const f32x4*)(p.x + (long)(blockIdx.x * 8 + wid) * DM);
#pragma unroll
    for (int i = 0; i < 8; ++i) xn[i] = __builtin_nontemporal_load(xr + i * 64 + lane);
  }
  for (int row = blockIdx.x * 8 + wid; row < MTOK; row += gridDim.x * 8) {
    f32x4 xv[8];
#pragma unroll
    for (int i = 0; i < 8; ++i) xv[i] = xn[i];
    if (row + (int)gridDim.x * 8 < MTOK) {
      const f32x4* xr = (const f32x4*)(p.x + (long)(row + gridDim.x * 8) * DM);
#pragma unroll
      for (int i = 0; i < 8; ++i) xn[i] = __builtin_nontemporal_load(xr + i * 64 + lane);
    }
    float ss = 0.f;
#pragma unroll
    for (int i = 0; i < 8; ++i) ss += xv[i][0] * xv[i][0] + xv[i][1] * xv[i][1] + xv[i][2] * xv[i][2] + xv[i][3] * xv[i][3];
    ss = wsum(ss);
    const float rs = rsqrtf(ss * (1.f / DM) + EPS);
    float f[8];
#pragma unroll
    for (int q = 0; q < 8; ++q) f[q] = 0.f;
#pragma unroll
    for (int i = 0; i < 8; ++i) {
      f32x4 g = ((const f32x4*)p.norm_g)[i * 64 + lane];
      float hv[4];
#pragma unroll
      for (int e = 0; e < 4; ++e) hv[e] = xv[i][e] * rs * g[e];
      u32x2 pk = {cvtpk(hv[0], hv[1]), cvtpk(hv[2], hv[3])};
      *(u32x2*)(p.hb + (long)row * DM + (i * 64 + lane) * 4) = pk;
#pragma unroll
      for (int e = 0; e < 4; ++e) {
        f32x4 wa = WF[((i * 4 + e) * 2 + 0) * 64 + lane], wb = WF[((i * 4 + e) * 2 + 1) * 64 + lane];
        f[0] += hv[e] * wa[0]; f[1] += hv[e] * wa[1]; f[2] += hv[e] * wa[2]; f[3] += hv[e] * wa[3];
        f[4] += hv[e] * wb[0]; f[5] += hv[e] * wb[1]; f[6] += hv[e] * wb[2]; f[7] += hv[e] * wb[3];
      }
      __builtin_amdgcn_sched_barrier(0);
    }
#pragma unroll
    for (int q = 0; q < 8; ++q) f[q] = wsum(f[q]);
    if (lane == 0) {
      const int b = row / SEQ, s = row % SEQ;
#pragma unroll
      for (int q = 0; q < 8; ++q) p.logf[(b * NH + q) * SEQ + s] = log_sigmoidf_(f[q] + p.b_f[q]);
    }
  }
  __syncthreads();
}

constexpr int BM = 256, BK = 64, HALF = 128, HT = HALF * BK;
constexpr int SHM_BYTES = 8 * HT * 2;
constexpr int SHM_TOTAL = 8 * 32 * 132 * 4;

__device__ __forceinline__ int lds_byte(int r, int c) {
  int st = (r >> 4) * 2 + (c >> 5), rr = r & 15, cc = c & 31, ob = rr * 64 + cc * 2;
  return st * 1024 + (ob ^ (((ob >> 9) & 1) << 5));
}
__device__ __forceinline__ void stage_rc(int b, int& R, int& C) {
  int st = b / 1024, sb = b % 1024, swz = sb ^ (((sb >> 9) & 1) << 5);
  R = (st >> 1) * 16 + swz / 64; C = (st & 1) * 32 + (swz % 64) / 2;
}

#define SA(b, h) ((u16*)smem + ((b) * 2 + (h)) * HT)
#define SB(b, h) ((u16*)smem + (4 + (b) * 2 + (h)) * HT)
#define STAGE(P, BASE, br, kt) do { const char* _u = (const char*)((BASE) + (long)(br) * KD + (long)(kt) * BK); \
    __builtin_amdgcn_global_load_lds((const unsigned*)(_u + soff0), (unsigned*)((char*)(P) + gtid * 16), 16, 0, 0); \
    __builtin_amdgcn_global_load_lds((const unsigned*)(_u + soff1), (unsigned*)((char*)(P) + gtid * 16 + 8192), 16, 0, 0); } while (0)
#define LDA(dst, b, h) for (int m = 0; m < 4; ++m) for (int k = 0; k < 2; ++k) \
    dst[m][k] = *reinterpret_cast<const bf16x8*>((char*)SA(b, h) + lds_byte(wr * 64 + m * 16 + fr, k * 32 + fq * 8))
#define LDB(dst, b, h) for (int n = 0; n < 2; ++n) for (int k = 0; k < 2; ++k) \
    dst[n][k] = *reinterpret_cast<const bf16x8*>((char*)SB(b, h) + lds_byte(wc * 32 + n * 16 + fr, k * 32 + fq * 8))
#define MMA(ai, bj, At, Bt_) do { __builtin_amdgcn_s_setprio(1); \
    for (int m = 0; m < 4; ++m) for (int n = 0; n < 2; ++n) for (int k = 0; k < 2; ++k) \
      acc[ai][bj][m][n] = __builtin_amdgcn_mfma_f32_16x16x32_bf16(Bt_[n][k], At[m][k], acc[ai][bj][m][n], 0, 0, 0); \
    __builtin_amdgcn_s_setprio(0); } while (0)
#define WAIT_V(n) asm volatile("s_waitcnt vmcnt(" #n ")" ::: "memory")
#define WAIT_L(n) asm volatile("s_waitcnt lgkmcnt(" #n ")" ::: "memory")
#define BAR __builtin_amdgcn_s_barrier()
#define SCHED __builtin_amdgcn_sched_barrier(0)

template <bool MID>
__device__ __forceinline__ void gemm_core(const u16* __restrict__ A, const u16* __restrict__ Bt, const int brow, const int bcol,
                                          f32x4 (&acc)[2][2][4][2], const float* __restrict__ ssq) {
  int gtid = threadIdx.x; asm volatile("" : "+v"(gtid));
  const int wid = gtid >> 6, lane = gtid & 63, wr = wid >> 2, wc = wid & 3, fr = lane & 15, fq = lane >> 4;
  unsigned soff0, soff1;
  { int r_, c_; stage_rc(gtid * 16, r_, c_); soff0 = (unsigned)(r_ * KD + c_) * 2u; stage_rc(gtid * 16 + 8192, r_, c_); soff1 = (unsigned)(r_ * KD + c_) * 2u; }
  bf16x8 At[4][2], B0[2][2], B1[2][2];
  constexpr int nt = KD / BK;
  STAGE(SB(0, 0), Bt, bcol, 0); STAGE(SA(0, 0), A, brow, 0);
  STAGE(SB(0, 1), Bt, bcol + HALF, 0); STAGE(SA(0, 1), A, brow + HALF, 0);
  if (wr == 1) BAR;
  WAIT_V(4); BAR;
  STAGE(SB(1, 0), Bt, bcol, 1); STAGE(SA(1, 0), A, brow, 1); STAGE(SB(1, 1), Bt, bcol + HALF, 1);
  WAIT_V(6); BAR;
  for (int t = 0; t < nt - 2; t += 2) {
    if (MID && t == 16) {
      const float* rt_ = (const float*)(smem + SHM_BYTES);
#pragma unroll
      for (int ai = 0; ai < 2; ++ai)
#pragma unroll
        for (int m = 0; m < 4; ++m) {
          const float ratio = rt_[ai * HALF + wr * 64 + m * 16 + fr];
#pragma unroll
          for (int bj = 0; bj < 2; ++bj)
#pragma unroll
            for (int n = 0; n < 2; ++n)
#pragma unroll
              for (int j = 0; j < 4; ++j) acc[ai][bj][m][n][j] *= ratio;
        }
    }
    LDB(B0, 0, 0); SCHED; LDA(At, 0, 0); STAGE(SA(1, 1), A, brow + HALF, t + 1);
    WAIT_L(8); BAR; WAIT_L(0); MMA(0, 0, At, B0); BAR; SCHED;
    LDB(B1, 0, 1); STAGE(SB(0, 0), Bt, bcol, t + 2);
    BAR; WAIT_L(0); MMA(0, 1, At, B1); BAR;
    LDA(At, 0, 1); STAGE(SA(0, 0), A, brow, t + 2);
    BAR; WAIT_L(0); MMA(1, 0, At, B0); BAR; SCHED;
    STAGE(SB(0, 1), Bt, bcol + HALF, t + 2);
    WAIT_V(6); BAR; MMA(1, 1, At, B1); BAR;
    LDB(B0, 1, 0); SCHED; LDA(At, 1, 0); STAGE(SA(0, 1), A, brow + HALF, t + 2);
    WAIT_L(8); BAR; WAIT_L(0); MMA(0, 0, At, B0); BAR; SCHED;
    LDB(B1, 1, 1); STAGE(SB(1, 0), Bt, bcol, t + 3);
    BAR; WAIT_L(0); MMA(0, 1, At, B1); BAR;
    LDA(At, 1, 1); STAGE(SA(1, 0), A, brow, t + 3);
    BAR; WAIT_L(0); MMA(1, 0, At, B0); BAR; SCHED;
    STAGE(SB(1, 1), Bt, bcol + HALF, t + 3);
    WAIT_V(6); BAR; MMA(1, 1, At, B1); BAR;
  }
  { LDB(B0, 0, 0); LDA(At, 0, 0); STAGE(SA(1, 1), A, brow + HALF, nt - 1);
    BAR; WAIT_L(0); MMA(0, 0, At, B0); BAR;
    LDB(B1, 0, 1); BAR; WAIT_L(0); MMA(0, 1, At, B1); BAR;
    LDA(At, 0, 1); WAIT_V(4); BAR; WAIT_L(0); MMA(1, 0, At, B0); MMA(1, 1, At, B1); BAR; }
  { LDB(B0, 1, 0); LDA(At, 1, 0); WAIT_V(2); BAR; WAIT_L(0); MMA(0, 0, At, B0); BAR;
    LDB(B1, 1, 1); WAIT_V(0); BAR; WAIT_L(0); MMA(0, 1, At, B1); BAR;
    LDA(At, 1, 1); BAR; WAIT_L(0); MMA(1, 0, At, B0); MMA(1, 1, At, B1); BAR; }
  if (wr == 0) BAR;
}

__device__ __forceinline__ void tile_map(int round, int nPatchN, int& pm, int& pn) {
  const int xcd = blockIdx.x & 7, local = blockIdx.x >> 3;
  const int patch = round * 8 + xcd;
  const int pmm = patch / nPatchN, pnn = patch % nPatchN;
  pm = pmm * 4 + (local & 3); pn = pnn * 8 + (local >> 2);
}

__device__ void phase_inproj(const Params& p) {
  for (int round = 0; round < 6; ++round) {
    int pm, pn; tile_map(round, 3, pm, pn);
    const int brow = pm * BM, bcol = pn * BM;
    f32x4 acc[2][2][4][2] = {};
    gemm_core<false>(p.hb, p.WinT, brow, bcol, acc, nullptr);
    __syncthreads();
    int tid = threadIdx.x; asm volatile("" : "+v"(tid));
    const int wid = tid >> 6, lane = tid & 63, wr = wid >> 2, wc = wid & 3, fr = lane & 15, fq = lane >> 4;
    const int region = pn >> 2;
    const int cofs = (pn & 3) * 256;
    const float osc = (region == 0) ? QSCALE : 1.f;
    u16* C16 = (u16*)smem;
    float kn2 = 0.f;
#pragma unroll
    for (int ai = 0; ai < 2; ++ai) {
      if (region != 2) {
#pragma unroll
        for (int bj = 0; bj < 2; ++bj)
#pragma unroll
          for (int m = 0; m < 4; ++m)
#pragma unroll
            for (int n = 0; n < 2; ++n) {
              const int r = wr * 64 + m * 16 + fr, c = bj * 128 + wc * 32 + n * 16 + fq * 4;
              u32x2 pk = {cvtpk(acc[ai][bj][m][n][0] * osc, acc[ai][bj][m][n][1] * osc), cvtpk(acc[ai][bj][m][n][2] * osc, acc[ai][bj][m][n][3] * osc)};
              *(u32x2*)(C16 + r * 264 + c) = pk;
            }
        __syncthreads();
        u16* dst = (region == 0) ? p.qb : (region == 1) ? p.kb : (region == 3) ? p.za : (region == 4) ? p.xl : p.zl;
#pragma unroll
        for (int i = 0; i < 8; ++i) {
          const int id = tid + NTHR * i, r = id >> 5, c8 = (id & 31) * 8;
          u32x4 v = *(const u32x4*)(C16 + r * 264 + c8);
          *(u32x4*)(dst + (long)(brow + ai * HALF + r) * 1024 + cofs + c8) = v;
          if (region == 1) {
            float s2 = 0.f;
#pragma unroll
            for (int e = 0; e < 4; ++e) { const float a = bflo(v[e]), bq = bfhi(v[e]); s2 += a * a + bq * bq; }
            s2 += __shfl_xor(s2, 1); s2 += __shfl_xor(s2, 2); s2 += __shfl_xor(s2, 4); s2 += __shfl_xor(s2, 8);
            kn2 = fmaxf(kn2, s2);
          }
        }
      } else {
#pragma unroll
        for (int bj = 0; bj < 2; ++bj)
#pragma unroll
          for (int m = 0; m < 4; ++m)
#pragma unroll
            for (int n = 0; n < 2; ++n) {
              const int r = wr * 64 + m * 16 + fr, c = bj * 128 + wc * 32 + n * 16 + fq * 4;
#pragma unroll
              for (int j = 0; j < 4; ++j) C16[(c + j) * 136 + r] = (u16)cvtpk(acc[ai][bj][m][n][j], 0.f);
            }
        __syncthreads();
        const int b = brow / SEQ, s0 = brow % SEQ + ai * HALF;
#pragma unroll
        for (int i = 0; i < 8; ++i) {
          const int id = tid + NTHR * i, c = id >> 4, r8 = (id & 15) * 8;
          u32x4 v = *(const u32x4*)(C16 + c * 136 + r8);
          const int head = (pn & 3) * 2 + (c >> 7), d = c & 127;
          *(u32x4*)(p.vT + ((long)(b * NH + head) * HD + d) * SEQ + s0 + r8) = v;
        }
      }
      __syncthreads();
    }
    if (region == 1) {
      kn2 = fmaxf(kn2, __shfl_xor(kn2, 32));
      if ((lane & 47) == 0)
        atomicMax((unsigned*)p.ssq + 3 * MTOK + (brow / SEQ) * NH + (pn & 3) * 2 + ((lane >> 4) & 1), __float_as_uint(kn2));
    }
  }
}

__device__ void cumsum_item(const Params& p, int bh) {
  int tid = threadIdx.x; asm volatile("" : "+v"(tid));
  const int lane = tid & 63, wid = tid >> 6;
  float* wtot = (float*)smem;
  const float* src = p.logf + bh * SEQ + tid * 16;
  float v[16];
#pragma unroll
  for (int i = 0; i < 4; ++i) { f32x4 t = *(const f32x4*)(src + i * 4); v[i * 4] = t[0]; v[i * 4 + 1] = t[1]; v[i * 4 + 2] = t[2]; v[i * 4 + 3] = t[3]; }
#pragma unroll
  for (int i = 1; i < 16; ++i) v[i] += v[i - 1];
  float tot = v[15], inc = tot;
#pragma unroll
  for (int o = 1; o < 64; o <<= 1) { float u = __shfl_up(inc, o); if (lane >= o) inc += u; }
  if (lane == 63) wtot[wid] = inc;
  __syncthreads();
  float base = inc - tot;
  for (int w = 0; w < wid; ++w) base += wtot[w];
  float* dst = p.c2 + bh * SEQ + tid * 16;
#pragma unroll
  for (int i = 0; i < 4; ++i) {
    f32x4 t = {(v[i * 4] + base) * LOG2E, (v[i * 4 + 1] + base) * LOG2E, (v[i * 4 + 2] + base) * LOG2E, (v[i * 4 + 3] + base) * LOG2E};
    *(f32x4*)(dst + i * 4) = t;
  }
  __syncthreads();
}

template <int PASS>
__device__ void lru_phase(const Params& p) {
  int tid = threadIdx.x; asm volatile("" : "+v"(tid));
  const int lane = tid & 63, w = tid >> 6, fr = lane & 15, fq = lane >> 4;
  const int nb = blockIdx.x & 7, c0 = blockIdx.x >> 3;
  u16* Ub = (u16*)smem;
  float* U32 = (float*)(smem + 17408);
  float* Ab = (float*)(smem + 50176);
  float* Bb = (float*)(smem + 82944);
  float* sgA = (float*)(smem + 115712);
  float* sgH = sgA + 512;
  const float* CY = (const float*)(smem + 126976);
  bf16x8 bR[4], bI[4];
  {
    const u16* wr_ = p.WgT + (long)nb * 16384 + (w * 16 + fr) * 128 + fq * 8;
    const u16* wi_ = p.WgT + (long)(8 + nb) * 16384 + (w * 16 + fr) * 128 + fq * 8;
#pragma unroll
    for (int ks = 0; ks < 4; ++ks) { bR[ks] = *(const bf16x8*)(wr_ + ks * 32); bI[ks] = *(const bf16x8*)(wi_ + ks * 32); }
  }
  const int c8 = (tid & 15) * 8, tr = tid >> 4, gc = nb * 128 + c8;
  float cw[4][8], cb[8];
#pragma unroll
  for (int k = 0; k < 4; ++k) {
    f32x4 a = *(const f32x4*)(p.conv_w + k * LW + gc), bq = *(const f32x4*)(p.conv_w + k * LW + gc + 4);
    cw[k][0] = a[0]; cw[k][1] = a[1]; cw[k][2] = a[2]; cw[k][3] = a[3]; cw[k][4] = bq[0]; cw[k][5] = bq[1]; cw[k][6] = bq[2]; cw[k][7] = bq[3];
  }
  { f32x4 a = *(const f32x4*)(p.conv_b + gc), bq = *(const f32x4*)(p.conv_b + gc + 4);
    cb[0] = a[0]; cb[1] = a[1]; cb[2] = a[2]; cb[3] = a[3]; cb[4] = bq[0]; cb[5] = bq[1]; cb[6] = bq[2]; cb[7] = bq[3]; }
  const int chE = w * 16 + fr, gchE = nb * 128 + chE;
  const float br = p.b_rg[gchE], bi = p.b_ig[gchE];
  const float sp = log1pf(__expf(-p.lam[gchE]));
  const int ch = tid & 127, seg = tid >> 7;
  const int to = tid >> 3, c16 = (tid & 7) * 16;
  u32x4 xr[2][4];
#define LRU_PREFETCH(i_) do { const int b_ = (i_) >> 2, s0_ = (c0 + 32 * ((i_) & 3)) * CHUNK; const long tokb_ = (long)b_ * SEQ; \
    _Pragma("unroll") for (int tt = 0; tt < 2; ++tt) _Pragma("unroll") for (int k = 0; k < 4; ++k) { \
      const int sp_ = s0_ + tr + tt * 32 - 3 + k; u32x4 z_ = {0u, 0u, 0u, 0u}; \
      xr[tt][k] = (sp_ >= 0) ? __builtin_nontemporal_load((const u32x4*)(p.xl + (tokb_ + sp_) * LW + gc)) : z_; } \
    } while (0)
  LRU_PREFETCH(0);
#pragma unroll 1
  for (int it = 0; it < 8; ++it) {
    const int b = it >> 2, chunk = c0 + 32 * (it & 3), s0 = chunk * CHUNK;
    const long tokb = (long)b * SEQ;
    u32x4 z0, z1;
    if (PASS == 2) { const u16* zp_ = p.zl + (tokb + s0 + to) * LW + nb * 128 + c16; z0 = __builtin_nontemporal_load((const u32x4*)zp_); z1 = __builtin_nontemporal_load((const u32x4*)(zp_ + 8)); }
#pragma unroll
    for (int tt = 0; tt < 2; ++tt) {
      const int t = tr + tt * 32;
      f2_t u2[4];
#pragma unroll
      for (int e = 0; e < 4; ++e) { f2_t c_ = {cb[2 * e], cb[2 * e + 1]}; u2[e] = c_; }
#pragma unroll
      for (int k = 0; k < 4; ++k)
#pragma unroll
        for (int e = 0; e < 4; ++e) {
          f2_t w_ = {cw[k][2 * e], cw[k][2 * e + 1]}, x_ = {bflo(xr[tt][k][e]), bfhi(xr[tt][k][e])};
          u2[e] = w_ * x_ + u2[e];
        }
      f32x4 u0 = {u2[0][0], u2[0][1], u2[1][0], u2[1][1]}, u1 = {u2[2][0], u2[2][1], u2[3][0], u2[3][1]};
      *(f32x4*)(U32 + t * 128 + c8) = u0; *(f32x4*)(U32 + t * 128 + c8 + 4) = u1;
      u32x4 pk = {cvtpk(u2[0][0], u2[0][1]), cvtpk(u2[1][0], u2[1][1]), cvtpk(u2[2][0], u2[2][1]), cvtpk(u2[3][0], u2[3][1])};
      *(u32x4*)(Ub + t * 136 + c8) = pk;
    }
    if (it + 1 < 8) LRU_PREFETCH(it + 1);
    __syncthreads();
    f32x4 aR[4] = {}, aI[4] = {};
    {
      bf16x8 af[4];
#define ALD(i) af[(i) & 3] = *(const bf16x8*)(Ub + (((i) & 3) * 16 + fr) * 136 + ((i) >> 2) * 32 + fq * 8)
      ALD(0); ALD(1); ALD(2);
#pragma unroll
      for (int i = 0; i < 16; ++i) {
        if (i + 3 < 16) ALD(i + 3);
        aR[i & 3] = __builtin_amdgcn_mfma_f32_16x16x32_bf16(af[i & 3], bR[i >> 2], aR[i & 3], 0, 0, 0);
        aI[i & 3] = __builtin_amdgcn_mfma_f32_16x16x32_bf16(af[i & 3], bI[i >> 2], aI[i & 3], 0, 0, 0);
        __builtin_amdgcn_sched_barrier(0);
      }
#undef ALD
    }
    {
      const f2_t nl2 = {-LOG2E, -LOG2E}, one = {1.f, 1.f};
      const f2_t brs = {br * -LOG2E, br * -LOG2E}, bis = {bi * -LOG2E, bi * -LOG2E};
      const float c1s = -8.f * sp * LOG2E;
      const f2_t c1 = {c1s, c1s};
#pragma unroll
      for (int m = 0; m < 4; ++m)
#pragma unroll
        for (int j = 0; j < 4; j += 2) {
          const int t = m * 16 + fq * 4 + j;
          f2_t xr2 = {aR[m][j], aR[m][j + 1]}, xi2 = {aI[m][j], aI[m][j + 1]};
          f2_t tr2 = xr2 * nl2 + brs, ti2 = xi2 * nl2 + bis;
          f2_t e1 = {__builtin_amdgcn_exp2f(tr2[0]), __builtin_amdgcn_exp2f(tr2[1])};
          f2_t e2 = {__builtin_amdgcn_exp2f(ti2[0]), __builtin_amdgcn_exp2f(ti2[1])};
          f2_t d1 = e1 + one, d2 = e2 + one;
          f2_t r2 = {__builtin_amdgcn_rcpf(d1[0]), __builtin_amdgcn_rcpf(d1[1])};
          f2_t ig2 = {__builtin_amdgcn_rcpf(d2[0]), __builtin_amdgcn_rcpf(d2[1])};
          f2_t ta = r2 * c1;
          f2_t a2 = {__builtin_amdgcn_exp2f(ta[0]), __builtin_amdgcn_exp2f(ta[1])};
          f2_t om = one - a2 * a2;
          f2_t mu = {__builtin_amdgcn_sqrtf(om[0]), __builtin_amdgcn_sqrtf(om[1])};
          f2_t uu = {U32[t * 128 + chE], U32[(t + 1) * 128 + chE]};
          f2_t bt = mu * ig2 * uu;
          Ab[t * 128 + chE] = a2[0]; Ab[(t + 1) * 128 + chE] = a2[1];
          Bb[t * 128 + chE] = bt[0]; Bb[(t + 1) * 128 + chE] = bt[1];
        }
    }
    __syncthreads();
    {
      float A = 1.f, H = 0.f;
#pragma unroll
      for (int i = 0; i < 16; ++i) { const int t = seg * 16 + i; const float a = Ab[t * 128 + ch]; H = a * H + Bb[t * 128 + ch]; A *= a; }
      sgA[seg * 128 + ch] = A; sgH[seg * 128 + ch] = H;
    }
    __syncthreads();
    if (PASS == 1) {
      if (tid < 128) {
        float A = 1.f, H = 0.f;
#pragma unroll
        for (int s = 0; s < 4; ++s) { const float a = sgA[s * 128 + ch]; H = a * H + sgH[s * 128 + ch]; A *= a; }
        const unsigned oi = (unsigned)((b * NCHUNK + chunk) * LW + nb * 128 + ch);
        p.lruA[oi] = A;
        p.lruH[oi] = H;
      }
    } else {
      float H = CY[it * 128 + ch];
#pragma unroll
      for (int s = 0; s < 3; ++s) if (s < seg) H = sgA[s * 128 + ch] * H + sgH[s * 128 + ch];
#pragma unroll
      for (int i = 0; i < 16; ++i) { const int t = seg * 16 + i; H = Ab[t * 128 + ch] * H + Bb[t * 128 + ch]; Bb[t * 128 + ch] = H; }
      __syncthreads();
      const long tok = tokb + s0 + to;
      float h[16], ss = 0.f;
#pragma unroll
      for (int i = 0; i < 4; ++i) { f32x4 v = *(const f32x4*)(Bb + to * 128 + c16 + i * 4); h[i * 4] = v[0]; h[i * 4 + 1] = v[1]; h[i * 4 + 2] = v[2]; h[i * 4 + 3] = v[3]; }
#pragma unroll
      for (int i = 0; i < 16; ++i) ss += h[i] * h[i];
      ss += __shfl_xor(ss, 1); ss += __shfl_xor(ss, 2); ss += __shfl_xor(ss, 4);
      if ((tid & 7) == 0) atomicAdd(p.ssq + MTOK + tok, ss);
      unsigned o[8];
#pragma unroll
      for (int i = 0; i < 8; ++i) {
        const unsigned zw = (i < 4) ? z0[i & 3] : z1[i & 3];
        const f2_t z2 = {bflo(zw), bfhi(zw)}, h2 = {h[2 * i], h[2 * i + 1]}, nl2 = {-LOG2E, -LOG2E}, one = {1.f, 1.f};
        const f2_t t2 = z2 * nl2;
        const f2_t e2 = {__builtin_amdgcn_exp2f(t2[0]), __builtin_amdgcn_exp2f(t2[1])};
        const f2_t d2 = e2 + one;
        const f2_t iv = {__builtin_amdgcn_rcpf(d2[0]), __builtin_amdgcn_rcpf(d2[1])};
        const f2_t ov = h2 * z2 * iv;
        o[i] = cvtpk(ov[0], ov[1]);
      }
      u16* op = p.mixed + tok * DM + AW + nb * 128 + c16;
      u32x4 o0 = {o[0], o[1], o[2], o[3]}, o1 = {o[4], o[5], o[6], o[7]};
      *(u32x4*)op = o0; *(u32x4*)(op + 8) = o1;
    }
  }
  __syncthreads();
#undef LRU_PREFETCH
}

__device__ void lru_carry_block(const Params& p) {
  float* CY = (float*)(smem + 126976);
  float* TA = (float*)smem;
  float* TH = TA + 512;
  int tid = threadIdx.x; asm volatile("" : "+v"(tid));
  const int ch = tid & 127, sg = tid >> 7;
  const int nb = blockIdx.x & 7, c0 = blockIdx.x >> 3;
  const int lo = (sg == 0) ? 0 : c0 + 32 * (sg - 1), hi = c0 + 32 * sg;
  float av[NB][32], hv[NB][32];
#pragma unroll
  for (int b = 0; b < NB; ++b) {
    const float* pa = p.lruA + ((long)b * NCHUNK) * LW + nb * 128 + ch;
    const float* ph = p.lruH + ((long)b * NCHUNK) * LW + nb * 128 + ch;
#pragma unroll
    for (int u = 0; u < 32; ++u) {
      const int c = lo + u;
      const bool ok = c < hi;
      av[b][u] = ok ? pa[(long)c * LW] : 1.f;
      hv[b][u] = ok ? ph[(long)c * LW] : 0.f;
    }
  }
#pragma unroll
  for (int b = 0; b < NB; ++b) {
    float A = 1.f, H = 0.f;
#pragma unroll
    for (int u = 0; u < 32; ++u) { H = av[b][u] * H + hv[b][u]; A *= av[b][u]; }
    TA[sg * 128 + ch] = A; TH[sg * 128 + ch] = H;
    __syncthreads();
    if (tid < 128) {
      float Hc = 0.f;
#pragma unroll
      for (int i = 0; i < 4; ++i) { Hc = TA[i * 128 + ch] * Hc + TH[i * 128 + ch]; CY[(b * 4 + i) * 128 + ch] = Hc; }
    }
    __syncthreads();
  }
}

__device__ void attn_item(const Params& p, int b, int h, int qblk) {
  int tid = threadIdx.x; asm volatile("" : "+v"(tid));
  const int lane = tid & 63, w = tid >> 6, c = lane & 31, hi = lane >> 5;
  char* Kl = smem;
  char* Vl = smem + 34816;
  float* Cl = (float*)(smem + 69632);
  const int P0 = qblk * 256;
  const int qrow = P0 + w * 32 + c;
  const long tokb = (long)b * SEQ;
  const int bh = b * NH + h;
  bf16x8 qf[8];
  {
    const u16* qp = p.qb + (tokb + qrow) * AW + h * HD + hi * 8;
#pragma unroll
    for (int d0 = 0; d0 < 8; ++d0) qf[d0] = *(const bf16x8*)(qp + d0 * 16);
  }
  const float* c2 = p.c2 + (long)bh * SEQ;
  float* Wm = (float*)(smem + 69632 + 512);
  float ebase;
  {
    float q2 = 0.f;
#pragma unroll
    for (int d0 = 0; d0 < 8; ++d0) {
      u32x4 t = __builtin_bit_cast(u32x4, qf[d0]);
#pragma unroll
      for (int e = 0; e < 4; ++e) { const float a = bflo(t[e]), bq = bfhi(t[e]); q2 += a * a + bq * bq; }
    }
    q2 = xh_sum(q2);
    const float kmax = sqrtf(__uint_as_float(((const unsigned*)p.ssq)[3 * MTOK + bh])) * 1.001f;
    ebase = sqrtf(q2) * 1.001f * kmax;
  }
  constexpr float T2 = 40.f;
  f32x16 o[4];
#pragma unroll
  for (int dt = 0; dt < 4; ++dt)
#pragma unroll
    for (int r = 0; r < 16; ++r) o[dt][r] = 0.f;
  float mrun = -1e30f, lrun = 0.f, ewave = __builtin_inff();
  const int jhi = 4 * qblk + 3;
  const int kkey = tid >> 3, kc = (tid & 7) * 16;
  const int vd = tid >> 2, vk = (tid & 3) * 16;
  const u16* kg = p.kb + (tokb + kkey) * AW + h * HD + kc;
  const u16* vg = p.vT + ((long)bh * HD + vd) * SEQ + vk;
  u32x4 sk0A, sk1A, sv0A, sv1A, sk0B, sk1B, sv0B, sv1B; float scA = 0.f, scB = 0.f;
#define AT_GLOAD(S, j) do { const u16* kp_ = kg + (long)(j) * 64 * AW; sk0##S = *(const u32x4*)kp_; sk1##S = *(const u32x4*)(kp_ + 8); \
    const u16* vp_ = vg + (j) * 64; sv0##S = *(const u32x4*)vp_; sv1##S = *(const u32x4*)(vp_ + 8); if (tid < 64) sc##S = c2[(j) * 64 + tid]; } while (0)
#define AT_LSTORE(S, bf) do { char* kd_ = Kl + (bf) * 17408 + kkey * 272 + kc * 2; *(u32x4*)kd_ = sk0##S; *(u32x4*)(kd_ + 16) = sk1##S; \
    char* vd_ = Vl + (bf) * 17408 + vd * 136 + vk * 2; u32x2 a0_ = {sv0##S[0], sv0##S[1]}, a1_ = {sv0##S[2], sv0##S[3]}, a2_ = {sv1##S[0], sv1##S[1]}, a3_ = {sv1##S[2], sv1##S[3]}; \
    *(u32x2*)vd_ = a0_; *(u32x2*)(vd_ + 8) = a1_; *(u32x2*)(vd_ + 16) = a2_; *(u32x2*)(vd_ + 24) = a3_; if (tid < 64) Cl[(bf) * 64 + tid] = -sc##S; } while (0)
  AT_GLOAD(A, jhi);
  AT_GLOAD(B, jhi - 1);
  AT_LSTORE(A, 0);
  AT_GLOAD(A, jhi - 2);
  __syncthreads();
  auto tile_body = [&](const int buf, const int j, const int it) __attribute__((always_inline)) {
    const int k0 = 64 * j;
    if (k0 <= P0 + w * 32 + 31 && !(ewave + Cl[buf * 64 + 63] <= -T2)) {
      f32x16 p0, p1;
      {
        const float* ck = Cl + buf * 64 + 4 * hi;
#pragma unroll
        for (int g = 0; g < 4; ++g) {
          f32x4 v0 = *(const f32x4*)(ck + 8 * g), v1 = *(const f32x4*)(ck + 32 + 8 * g);
#pragma unroll
          for (int e = 0; e < 4; ++e) { p0[4 * g + e] = v0[e]; p1[4 * g + e] = v1[e]; }
        }
      }
      const char* kb_ = Kl + buf * 17408 + c * 272 + hi * 16;
      {
        bf16x8 kf[4][2];
#define KLD(d) do { kf[(d) & 3][0] = *(const bf16x8*)(kb_ + (d) * 32); kf[(d) & 3][1] = *(const bf16x8*)(kb_ + 32 * 272 + (d) * 32); } while (0)
        KLD(0); KLD(1); KLD(2);
        __builtin_amdgcn_s_setprio(1);
#pragma unroll
        for (int d0 = 0; d0 < 8; ++d0) {
          if (d0 + 3 < 8) KLD(d0 + 3);
          p0 = __builtin_amdgcn_mfma_f32_32x32x16_bf16(kf[d0 & 3][0], qf[d0], p0, 0, 0, 0);
          p1 = __builtin_amdgcn_mfma_f32_32x32x16_bf16(kf[d0 & 3][1], qf[d0], p1, 0, 0, 0);
          __builtin_amdgcn_sched_barrier(0);
        }
        __builtin_amdgcn_s_setprio(0);
#undef KLD
      }
      if (k0 + 63 > P0 + w * 32) {
        const float NEG = -__builtin_inff();
#pragma unroll
        for (int r = 0; r < 16; ++r) {
          const int key = k0 + (r & 3) + 8 * (r >> 2) + 4 * hi;
          if (key > qrow) p0[r] = NEG;
          if (key + 32 > qrow) p1[r] = NEG;
        }
      }
      float mx;
      {
        f32x16 mv = __builtin_elementwise_max(p0, p1);
        float m8[8];
#pragma unroll
        for (int r = 0; r < 8; ++r) m8[r] = fmaxf(mv[r], mv[r + 8]);
        mx = fmaxf(fmaxf(fmaxf(m8[0], m8[1]), fmaxf(m8[2], m8[3])), fmaxf(fmaxf(m8[4], m8[5]), fmaxf(m8[6], m8[7])));
      }
      mx = xh_max(mx);
      const float mn = fmaxf(mrun, mx);
      const float alpha = __builtin_amdgcn_exp2f(mrun - mn);
      mrun = mn;
      const bool moved = !__all(alpha == 1.f);
      if (moved) {
        float e = ebase - mn;
        e = fmaxf(e, __shfl_xor(e, 16)); e = fmaxf(e, __shfl_xor(e, 8)); e = fmaxf(e, __shfl_xor(e, 4));
        e = fmaxf(e, __shfl_xor(e, 2)); e = fmaxf(e, __shfl_xor(e, 1));
        ewave = e;
      }
      float ps;
      {
        p0 = p0 - mn; p1 = p1 - mn;
#pragma unroll
        for (int r = 0; r < 16; ++r) { p0[r] = __builtin_amdgcn_exp2f(p0[r]); p1[r] = __builtin_amdgcn_exp2f(p1[r]); }
        f32x16 sv = p0 + p1;
        f2_t s2 = {0.f, 0.f};
#pragma unroll
        for (int r = 0; r < 16; r += 2) { f2_t t_ = {sv[r], sv[r + 1]}; s2 += t_; }
        ps = s2[0] + s2[1];
      }
      ps = xh_sum(ps);
      lrun = lrun * alpha + ps;
      if (moved) {
#pragma unroll
        for (int dt = 0; dt < 4; ++dt)
#pragma unroll
          for (int r = 0; r < 16; ++r) o[dt][r] *= alpha;
      }
      bf16x8 pb[4];
      { u32x4 t0 = {cvtpk(p0[0], p0[1]), cvtpk(p0[2], p0[3]), cvtpk(p0[4], p0[5]), cvtpk(p0[6], p0[7])};
        u32x4 t1 = {cvtpk(p0[8], p0[9]), cvtpk(p0[10], p0[11]), cvtpk(p0[12], p0[13]), cvtpk(p0[14], p0[15])};
        u32x4 t2 = {cvtpk(p1[0], p1[1]), cvtpk(p1[2], p1[3]), cvtpk(p1[4], p1[5]), cvtpk(p1[6], p1[7])};
        u32x4 t3 = {cvtpk(p1[8], p1[9]), cvtpk(p1[10], p1[11]), cvtpk(p1[12], p1[13]), cvtpk(p1[14], p1[15])};
        pb[0] = __builtin_bit_cast(bf16x8, t0); pb[1] = __builtin_bit_cast(bf16x8, t1);
        pb[2] = __builtin_bit_cast(bf16x8, t2); pb[3] = __builtin_bit_cast(bf16x8, t3); }
      const char* vb_ = Vl + buf * 17408 + c * 136 + hi * 8;
      {
        u32x4 vv[4];
#define VLD(i) do { const char* a_ = vb_ + ((i) & 3) * 4352 + ((i) >> 2) * 32; u32x2 lo_ = *(const u32x2*)a_, hh_ = *(const u32x2*)(a_ + 16); \
          u32x4 t_ = {lo_[0], lo_[1], hh_[0], hh_[1]}; vv[(i) & 3] = t_; } while (0)
        VLD(0); VLD(1); VLD(2);
        __builtin_amdgcn_s_setprio(1);
#pragma unroll
        for (int i = 0; i < 16; ++i) {
          if (i + 3 < 16) VLD(i + 3);
          o[i & 3] = __builtin_amdgcn_mfma_f32_32x32x16_bf16(__builtin_bit_cast(bf16x8, vv[i & 3]), pb[i >> 2], o[i & 3], 0, 0, 0);
          __builtin_amdgcn_sched_barrier(0);
        }
        __builtin_amdgcn_s_setprio(0);
#undef VLD
      }
    }
    if (lane == 0 && k0 <= P0 + w * 32 + 31) Wm[(it & 1) * 8 + w] = ewave;
  };
#define AT_EXIT(buf_, it_) ((it_) >= 4 && ({ const float* wm = Wm + (((it_) - 1) & 1) * 8; \
      fmaxf(fmaxf(fmaxf(wm[0], wm[1]), fmaxf(wm[2], wm[3])), fmaxf(fmaxf(wm[4], wm[5]), fmaxf(wm[6], wm[7]))); }) + Cl[(buf_) * 64 + 63] <= -T2)
  int it = 0, j = jhi;
  for (;;) {
    if (AT_EXIT(0, it)) break;
    if (j > 0) AT_LSTORE(B, 1);
    if (j > 2) AT_GLOAD(B, j - 3);
    tile_body(0, j, it);
    __syncthreads();
    --j; ++it;
    if (j < 0) break;
    if (AT_EXIT(1, it)) break;
    if (j > 0) AT_LSTORE(A, 0);
    if (j > 2) AT_GLOAD(A, j - 3);
    tile_body(1, j, it);
    __syncthreads();
    --j; ++it;
    if (j < 0) break;
  }
#undef AT_EXIT
#undef AT_GLOAD
#undef AT_LSTORE
  u32x4 zz8[8];
#pragma unroll
  for (int i = 0; i < 8; ++i) {
    const int id = lane + 64 * i, row = id >> 4, d8 = (id & 15) * 8;
    zz8[i] = __builtin_nontemporal_load((const u32x4*)(p.za + (tokb + P0 + w * 32 + row) * AW + h * HD + d8));
  }
  __builtin_amdgcn_sched_barrier(0);
  const float inv = 1.f / lrun;
  float ss = 0.f;
#pragma unroll
  for (int dt = 0; dt < 4; ++dt)
#pragma unroll
    for (int r = 0; r < 16; ++r) { o[dt][r] *= inv; ss += o[dt][r] * o[dt][r]; }
  ss = xh_sum(ss);
  __syncthreads();
  float* Ot = (float*)smem + w * (32 * 132);
#pragma unroll
  for (int dt = 0; dt < 4; ++dt)
#pragma unroll
    for (int g = 0; g < 4; ++g) {
      f32x4 v = {o[dt][4 * g], o[dt][4 * g + 1], o[dt][4 * g + 2], o[dt][4 * g + 3]};
      *(f32x4*)(Ot + c * 132 + dt * 32 + 8 * g + 4 * hi) = v;
    }
#pragma unroll
  for (int i = 0; i < 8; ++i) {
    const int id = lane + 64 * i, row = id >> 4, d8 = (id & 15) * 8;
    const long tr = tokb + P0 + w * 32 + row;
    const u32x4 zz = zz8[i];
    f32x4 a0 = *(const f32x4*)(Ot + row * 132 + d8), a1 = *(const f32x4*)(Ot + row * 132 + d8 + 4);
    u32x4 ov = {cvtpk(a0[0] * siluf_(bflo(zz[0])), a0[1] * siluf_(bfhi(zz[0]))), cvtpk(a0[2] * siluf_(bflo(zz[1])), a0[3] * siluf_(bfhi(zz[1]))),
                cvtpk(a1[0] * siluf_(bflo(zz[2])), a1[1] * siluf_(bfhi(zz[2]))), cvtpk(a1[2] * siluf_(bflo(zz[3])), a1[3] * siluf_(bfhi(zz[3])))};
    *(u32x4*)(p.mixed + tr * DM + h * HD + d8) = ov;
  }
  if (hi == 0) atomicAdd(p.ssq + tokb + qrow, ss);
}

__device__ void phase_outproj(const Params& p) {
  for (int round = 0; round < 2; ++round) {
    int pm, pn; tile_map(round, 1, pm, pn);
    const int brow = pm * BM, bcol = pn * BM;
    f32x4 acc[2][2][4][2] = {};
    {
      const int t_ = threadIdx.x;
      if (t_ < BM) {
        const float ra = __builtin_amdgcn_rsqf(p.ssq[brow + t_] * (1.f / AW) + EPS), rl = __builtin_amdgcn_rsqf(p.ssq[MTOK + brow + t_] * (1.f / LW) + EPS);
        ((float*)(smem + SHM_BYTES))[t_] = ra * __builtin_amdgcn_rcpf(rl);
      }
    }
    gemm_core<true>(p.mixed, p.WoutT, brow, bcol, acc, p.ssq);
    __syncthreads();
    int tid = threadIdx.x; asm volatile("" : "+v"(tid));
    const int wid = tid >> 6, lane = tid & 63, wr = wid >> 2, wc = wid & 3, fr = lane & 15, fq = lane >> 4;
    const int rg = lane >> 4, l16 = lane & 15;
    float* C32 = (float*)smem;
    f32x4 y[2][4][4];
#define XLOAD(ai) do { _Pragma("unroll") for (int i = 0; i < 4; ++i) { const unsigned grow = brow + (ai) * HALF + i * 32 + wid * 4 + rg; \
      const unsigned xo = grow * DM + bcol + l16 * 4; \
      _Pragma("unroll") for (int k = 0; k < 4; ++k) y[ai][i][k] = __builtin_nontemporal_load((const f32x4*)(p.x + xo + 64 * k)); } } while (0)
#define CSTAGE(ai) do { _Pragma("unroll") for (int bj = 0; bj < 2; ++bj) _Pragma("unroll") for (int m = 0; m < 4; ++m) \
      _Pragma("unroll") for (int n = 0; n < 2; ++n) { \
        const int r = wr * 64 + m * 16 + fr, c = bj * 128 + wc * 32 + n * 16 + fq * 4; \
        *(f32x4*)(C32 + r * 256 + (c ^ (fr << 2))) = acc[ai][bj][m][n]; } } while (0)
#define YCOMB(ai) do { float sq_[4]; _Pragma("unroll") for (int i = 0; i < 4; ++i) sq_[i] = p.ssq[MTOK + brow + (ai) * HALF + i * 32 + wid * 4 + rg]; \
    _Pragma("unroll") for (int i = 0; i < 4; ++i) { const int row = i * 32 + wid * 4 + rg; \
      const float rl_ = __builtin_amdgcn_rsqf(sq_[i] * (1.f / LW) + EPS); float sq = 0.f; \
      _Pragma("unroll") for (int k = 0; k < 4; ++k) { const int c4 = l16 * 4 + 64 * k; \
        f32x4 a = *(const f32x4*)(C32 + row * 256 + (c4 ^ ((((wid & 3) << 2) + rg) << 2))); f32x4 yv = y[ai][i][k]; \
        yv[0] += rl_ * a[0]; yv[1] += rl_ * a[1]; yv[2] += rl_ * a[2]; yv[3] += rl_ * a[3]; y[ai][i][k] = yv; \
        sq += yv[0] * yv[0] + yv[1] * yv[1] + yv[2] * yv[2] + yv[3] * yv[3]; } \
      sq += __shfl_xor(sq, 1); sq += __shfl_xor(sq, 2); sq += __shfl_xor(sq, 4); sq += __shfl_xor(sq, 8); sq_[i] = sq; } \
      if (l16 == 0) { _Pragma("unroll") for (int i = 0; i < 4; ++i) atomicAdd(p.ssq + 2 * MTOK + brow + (ai) * HALF + i * 32 + wid * 4 + rg, sq_[i]); } } while (0)
    CSTAGE(0);
    XLOAD(0);
    __syncthreads();
    XLOAD(1);
    YCOMB(0);
    __syncthreads();
    CSTAGE(1);
    __syncthreads();
    YCOMB(1);
#undef XLOAD
#undef CSTAGE
#undef YCOMB
    unsigned* cnt = (unsigned*)p.ssq + 3 * MTOK + 16 + pm;
    asm volatile("s_waitcnt vmcnt(0)" ::: "memory");
    __syncthreads();
    if (tid == 0) {
      __threadfence();
      atomicAdd(cnt, 1u);
      while (__hip_atomic_load(cnt, __ATOMIC_ACQUIRE, __HIP_MEMORY_SCOPE_AGENT) < 8u) __builtin_amdgcn_s_sleep(2);
    }
    __syncthreads();
    float sy[2][4];
#pragma unroll
    for (int ai = 0; ai < 2; ++ai)
#pragma unroll
      for (int i = 0; i < 4; ++i)
        sy[ai][i] = __hip_atomic_load(p.ssq + 2 * MTOK + brow + ai * HALF + i * 32 + wid * 4 + rg, __ATOMIC_RELAXED, __HIP_MEMORY_SCOPE_AGENT);
    f32x4 g[4];
#pragma unroll
    for (int k = 0; k < 4; ++k) g[k] = *(const f32x4*)(p.fg + bcol + l16 * 4 + 64 * k);
#pragma unroll
    for (int ai = 0; ai < 2; ++ai)
#pragma unroll
      for (int i = 0; i < 4; ++i) {
        const unsigned xo = (unsigned)(brow + ai * HALF + i * 32 + wid * 4 + rg) * DM + bcol + l16 * 4;
        const float rs = __builtin_amdgcn_rsqf(sy[ai][i] * (1.f / DM) + EPS);
#pragma unroll
        for (int k = 0; k < 4; ++k) {
          f32x4 yv = y[ai][i][k];
          f32x4 o = {yv[0] * rs * g[k][0], yv[1] * rs * g[k][1], yv[2] * rs * g[k][2], yv[3] * rs * g[k][3]};
          __builtin_nontemporal_store(o, (f32x4*)(p.out + xo + 64 * k));
        }
      }
    __syncthreads();
  }
}

#define XB_TMO      128
#define XB_XCNT(j)  (256  + 64 * (j))
#define XB_XSUB(j)  (1280 + 64 * (j))
#define XB_XGEN(j)  (2304 + 64 * (j))
#define XB_TOP      3328
#define XB_TOPGEN   3392
#define XCD_BAR_WORDS 3456
#define XB_SPIN_CAP (1u << 18)
#define LAS __attribute__((address_space(3)))

__device__ __forceinline__ unsigned xb_ld(unsigned* p)              { return __hip_atomic_load(p, __ATOMIC_RELAXED, __HIP_MEMORY_SCOPE_AGENT); }
__device__ __forceinline__ unsigned xb_add(unsigned* p, unsigned v) { return __hip_atomic_fetch_add(p, v, __ATOMIC_RELAXED, __HIP_MEMORY_SCOPE_AGENT); }
__device__ __forceinline__ unsigned xb_xcc_id() { return (unsigned)__builtin_amdgcn_s_getreg((3 << 11) | 20) & 0xFu; }
#define XB_SPIN(cond, bar) do { unsigned _sp = 0; while (cond) { __builtin_amdgcn_s_sleep(1); \
    if ((++_sp & 255u) == 0u) { if (xb_ld(&(bar)[XB_TMO])) break; if (_sp > XB_SPIN_CAP) { atomicAdd(&(bar)[XB_TMO], 1u); break; } } } } while (0)

struct XcdBarrier {
    unsigned* bar; unsigned x;
    volatile LAS unsigned* st;
};

__device__ __forceinline__ XcdBarrier xcd_barrier_post(unsigned* bar, volatile LAS unsigned* st) {
    XcdBarrier b; b.bar = bar; b.x = xb_xcc_id(); b.st = st;
    if (threadIdx.x == 0) (void)xb_add(&bar[XB_XCNT(b.x)], 1u);
    return b;
}
__device__ __forceinline__ void xcd_barrier_complete(unsigned* bar, unsigned x, unsigned& nloc, unsigned& nx) {
    const unsigned G = gridDim.x * gridDim.y * gridDim.z;
    unsigned sum, cnt, mine, sp = 0u;
    for (;;) {
        sum = 0u; cnt = 0u; mine = 0u;
#pragma unroll
        for (unsigned j = 0; j < 16; ++j) { const unsigned c = xb_ld(&bar[XB_XCNT(j)]); sum += c; cnt += (c > 0u) ? 1u : 0u; mine = (j == x) ? c : mine; }
        if (sum == G) break;
        __builtin_amdgcn_s_sleep(1);
        if ((++sp & 255u) == 0u) { if (xb_ld(&bar[XB_TMO])) break; if (sp > XB_SPIN_CAP) { atomicAdd(&bar[XB_TMO], 1u); break; } }
    }
    nloc = mine > 0u ? mine : 1u; nx = cnt > 0u ? cnt : 1u;
}

__device__ __forceinline__ void xcd_barrier(const XcdBarrier& b) {
    asm volatile("s_waitcnt vmcnt(0)" ::: "memory");
    __syncthreads();
    if (threadIdx.x == 0) {
        unsigned* bar = b.bar;
        __builtin_amdgcn_s_waitcnt(0);
        unsigned nloc = b.st[0], nx = b.st[1];
        if (nloc == 0u) { xcd_barrier_complete(bar, b.x, nloc, nx); b.st[0] = nloc; b.st[1] = nx; }
        const unsigned old = xb_add(&bar[XB_XSUB(b.x)], 1u);
        const unsigned gen = old / nloc;
        if (old + 1u == (gen + 1u) * nloc) {
            __builtin_amdgcn_fence(__ATOMIC_RELEASE, "agent");
            asm volatile("s_waitcnt vmcnt(0)" ::: "memory");
            const unsigned og = xb_add(&bar[XB_TOP], 1u);
            const unsigned tg = og / nx;
            if (og + 1u == (tg + 1u) * nx) xb_add(&bar[XB_TOPGEN], 1u);
            else XB_SPIN(xb_ld(&bar[XB_TOPGEN]) == tg, bar);
            __builtin_amdgcn_fence(__ATOMIC_ACQUIRE, "agent");
            xb_add(&bar[XB_XGEN(b.x)], 1u);
            asm volatile("s_waitcnt vmcnt(0)" ::: "memory");
        } else {
            XB_SPIN(xb_ld(&bar[XB_XGEN(b.x)]) == gen, bar);
            __builtin_amdgcn_fence(__ATOMIC_ACQUIRE, "agent");
            asm volatile("s_waitcnt vmcnt(0)" ::: "memory");
        }
    }
    __syncthreads();
}


__device__ __forceinline__ void phase_c(const Params& p) {
  if (blockIdx.x < NB * NH) cumsum_item(p, blockIdx.x);
  lru_phase<1>(p);
}
__device__ __forceinline__ void phase_d(const Params& p) {
  lru_carry_block(p);
  lru_phase<2>(p);
  for (int it = blockIdx.x; it < NB * NH * 16; it += gridDim.x) {
    const int b = it >> 7, hr = (it >> 4) & 7, xq = it & 15;
    int h1 = 0, h2 = 0;
#pragma unroll
    for (int h = 0; h < NH; ++h) {
      int rank = 0;
      const float bh_ = p.b_f[h];
#pragma unroll
      for (int g = 0; g < NH; ++g) { const float bg = p.b_f[g]; rank += (bg < bh_ || (bg == bh_ && g < h)) ? 1 : 0; }
      if (rank == hr) h1 = h;
      if (rank == 7 - hr) h2 = h;
    }
    attn_item(p, b, h1, 31 - xq);
    __syncthreads();
    attn_item(p, b, h2, xq);
    __syncthreads();
  }
}

__global__ void __launch_bounds__(NTHR, 2) hymba_fwd(Params p) {
  cg::grid_group grid = cg::this_grid();
  __shared__ uint4 xb_words;
  if (threadIdx.x == 0) xb_words = make_uint4(0u, 0u, 0u, 0u);
  __syncthreads();
#define SEAM() do { XcdBarrier xb_; xb_.bar = p.bar; xb_.x = xb_xcc_id(); xb_.st = (volatile LAS unsigned*)&xb_words; xcd_barrier(xb_); } while (0)
  (void)xcd_barrier_post(p.bar, (volatile LAS unsigned*)&xb_words);
  phase_prep(p);
  if (p.bar == nullptr) grid.sync(); else SEAM();
  phase_inproj(p);
  SEAM();
  phase_c(p);
  SEAM();
  phase_d(p);
  SEAM();
  phase_outproj(p);
#undef SEAM
}

extern "C" void kernel_launch(void* const* d_in, const int* in_sizes, int n_in, void* d_out, int out_size, void* d_ws, size_t ws_size,
                              hipStream_t stream) {
  Params p{};
  p.x = (const float*)d_in[0]; p.norm_g = (const float*)d_in[1]; p.w_in = (const float*)d_in[2]; p.b_f = (const float*)d_in[3];
  p.conv_w = (const float*)d_in[4]; p.conv_b = (const float*)d_in[5]; p.w_rg = (const float*)d_in[6]; p.b_rg = (const float*)d_in[7];
  p.w_ig = (const float*)d_in[8]; p.b_ig = (const float*)d_in[9]; p.lam = (const float*)d_in[10]; p.ag = (const float*)d_in[11];
  p.lg = (const float*)d_in[12]; p.w_out = (const float*)d_in[13]; p.fg = (const float*)d_in[14];
  p.out = (float*)d_out;
  char* ws = (char*)d_ws; size_t off = 0;
  auto take = [&](size_t bytes) { char* r = ws + off; off += (bytes + 255) & ~(size_t)255; return r; };
  p.hb = (u16*)take((size_t)MTOK * DM * 2);
  p.WinT = (u16*)take((size_t)NP * KD * 2);
  p.WoutT = (u16*)take((size_t)DM * KD * 2);
  p.WgT = (u16*)take((size_t)16 * 128 * 128 * 2);
  p.qb = (u16*)take((size_t)MTOK * AW * 2);
  p.kb = (u16*)take((size_t)MTOK * AW * 2);
  p.vT = (u16*)take((size_t)MTOK * AW * 2);
  p.za = (u16*)take((size_t)MTOK * AW * 2);
  p.xl = (u16*)take((size_t)MTOK * LW * 2);
  p.zl = (u16*)take((size_t)MTOK * LW * 2);
  p.mixed = (u16*)take((size_t)MTOK * DM * 2);
  p.logf = (float*)take((size_t)NB * NH * SEQ * 4);
  p.c2 = (float*)take((size_t)NB * NH * SEQ * 4);
  p.ssq = (float*)take((size_t)(3 * MTOK + 16 + 64) * 4);
  p.lruA = (float*)take((size_t)NB * NCHUNK * LW * 4);
  p.lruH = (float*)take((size_t)NB * NCHUNK * LW * 4);
  p.bar = (unsigned*)take((size_t)4096 * 4);

  static int grid_blocks = 0;
  if (!grid_blocks) {
    hipFuncSetAttribute((const void*)hymba_fwd, hipFuncAttributeMaxDynamicSharedMemorySize, SHM_TOTAL);
    int dev = 0, cus = 0, per_cu = 0;
    hipGetDevice(&dev);
    hipDeviceGetAttribute(&cus, hipDeviceAttributeMultiprocessorCount, dev);
    hipOccupancyMaxActiveBlocksPerMultiprocessor(&per_cu, hymba_fwd, NTHR, SHM_TOTAL);
    if (per_cu < 1) per_cu = 1;
    grid_blocks = 256;
    (void)per_cu; (void)cus;
  }
  hipMemsetAsync(p.bar, 0, (size_t)4096 * 4, stream);
  void* args[] = {&p};
  hipError_t e = hipLaunchCooperativeKernel((const void*)hymba_fwd, dim3(grid_blocks), dim3(NTHR), args, SHM_TOTAL, stream);
  if (e != hipSuccess) fprintf(stderr, "cooperative launch failed: %s (grid %d)\n", hipGetErrorString(e), grid_blocks);
}
```

```cpp
#include <hip/hip_runtime.h>
#include <hip/hip_bf16.h>
#include <hip/hip_cooperative_groups.h>
#include <cstdio>
#include <cstdint>
namespace cg = cooperative_groups;

typedef unsigned short u16;
typedef short bf16x8 __attribute__((ext_vector_type(8)));
typedef float f32x4 __attribute__((ext_vector_type(4)));
typedef float f32x16 __attribute__((ext_vector_type(16)));
typedef unsigned u32x4 __attribute__((ext_vector_type(4)));
typedef unsigned u32x2 __attribute__((ext_vector_type(2)));
typedef __bf16 bf2_t __attribute__((ext_vector_type(2)));
typedef float f2_t __attribute__((ext_vector_type(2)));

#ifndef SINGLE_LAUNCH
#define SINGLE_LAUNCH 1
#endif

constexpr int NB = 2, SEQ = 8192, DM = 2048, MTOK = NB * SEQ, NH = 8, HD = 128, AW = 1024, LW = 1024;
constexpr int NIN = 6152, NP = 6144, KD = 2048;
constexpr int NTHR = 512;
constexpr float EPS = 1e-6f;
constexpr float LOG2E = 1.4426950408889634f;
constexpr float QSCALE = 0.08838834764831845f * 1.4426950408889634f;
constexpr int CHUNK = 64, NCHUNK = SEQ / CHUNK;

struct Params {
  const float *x, *norm_g, *w_in, *b_f, *conv_w, *conv_b, *w_rg, *b_rg, *w_ig, *b_ig, *lam, *ag, *lg, *w_out, *fg;
  float* out;
  u16 *hb, *WinT, *WoutT, *WgT, *qb, *kb, *vT, *za, *xl, *zl, *mixed;
  float *logf, *c2, *ssq, *lruA, *lruH;
  unsigned* bar;
};

extern __shared__ __attribute__((aligned(16))) char smem[];

__device__ __forceinline__ unsigned cvtpk(float lo, float hi) {
  f2_t v = {lo, hi}; bf2_t r = __builtin_convertvector(v, bf2_t); return __builtin_bit_cast(unsigned, r);
}
__device__ __forceinline__ float bflo(unsigned u) { return __uint_as_float(u << 16); }
__device__ __forceinline__ float bfhi(unsigned u) { return __uint_as_float(u & 0xffff0000u); }
__device__ __forceinline__ float wsum(float v) {
#pragma unroll
  for (int o = 32; o; o >>= 1) v += __shfl_xor(v, o);
  return v;
}
__device__ __forceinline__ float xh_max(float v) {
  auto rr = __builtin_amdgcn_permlane32_swap(__float_as_uint(v), __float_as_uint(v), false, false);
  return fmaxf(__uint_as_float(rr[0]), __uint_as_float(rr[1]));
}
__device__ __forceinline__ float xh_sum(float v) {
  auto rr = __builtin_amdgcn_permlane32_swap(__float_as_uint(v), __float_as_uint(v), false, false);
  return __uint_as_float(rr[0]) + __uint_as_float(rr[1]);
}
__device__ __forceinline__ float frcp_(float x) { return __builtin_amdgcn_rcpf(x); }
__device__ __forceinline__ float fexp_(float x) { return __builtin_amdgcn_exp2f(x * LOG2E); }
__device__ __forceinline__ float sigmoidf_(float x) { return frcp_(1.f + fexp_(-x)); }
__device__ __forceinline__ float siluf_(float x) { return x * frcp_(1.f + fexp_(-x)); }
__device__ __forceinline__ float log_sigmoidf_(float x) { return fminf(x, 0.f) - log1pf(__expf(-fabsf(x))); }

struct TrDesc { const float* src; u16* dst; const float* ksc; int ld_src, ld_dst; };
__device__ __forceinline__ TrDesc tr_desc(const Params& p, int t) {
  TrDesc d;
  if (t < 3072) {
    const int kt = t & 31, nt = t >> 5, n0 = nt * 64;
    const int sc0 = n0 + (n0 >= 3072 ? 8 : 0);
    d.src = p.w_in + (long)kt * 64 * NIN + sc0; d.ld_src = NIN; d.dst = p.WinT + (long)n0 * KD + kt * 64; d.ld_dst = KD; d.ksc = nullptr;
  } else if (t < 4096) {
    const int u = t - 3072, kt = u & 31, nt = u >> 5;
    d.ksc = (kt < 16) ? (p.ag + kt * 64) : (p.lg + (kt - 16) * 64);
    d.src = p.w_out + (long)kt * 64 * DM + nt * 64; d.ld_src = DM; d.dst = p.WoutT + (long)nt * 64 * KD + kt * 64; d.ld_dst = KD;
  } else {
    const int u = t - 4096, mat = u >> 2, sub = u & 3, kt = sub & 1, nt = sub >> 1;
    const float* sm = (mat < 8) ? (p.w_rg + mat * 16384) : (p.w_ig + (mat - 8) * 16384);
    d.src = sm + kt * 64 * 128 + nt * 64; d.ld_src = 128; d.dst = p.WgT + mat * 16384 + nt * 64 * 128 + kt * 64; d.ld_dst = 128; d.ksc = nullptr;
  }
  return d;
}

__device__ void phase_prep(const Params& p) {
  int tid = threadIdx.x; asm volatile("" : "+v"(tid));
  const int lane = tid & 63, wid = tid >> 6;
  for (int i = blockIdx.x * NTHR + tid; i < 3 * MTOK + 16 + 64; i += gridDim.x * NTHR) p.ssq[i] = 0.f;
  {
    constexpr int NT = 3072 + 1024 + 64;
    float* T = (float*)smem + wid * (64 * 65);
    const int r4 = lane >> 4, c4 = (lane & 15) * 4;
    const int n8 = lane >> 3, k8 = (lane & 7) * 8;
    for (int t = blockIdx.x * 8 + wid; t < NT; t += 8 * gridDim.x) {
      const TrDesc d = tr_desc(p, t);
      f32x4 v[16]; float sc[16];
#pragma unroll
      for (int i = 0; i < 16; ++i) {
        const int rr = i * 4 + r4;
        v[i] = __builtin_nontemporal_load((const f32x4*)(d.src + (long)rr * d.ld_src + c4));
        sc[i] = d.ksc ? d.ksc[rr] : 1.f;
      }
#pragma unroll
      for (int i = 0; i < 16; ++i) {
        const int rr = i * 4 + r4;
        T[rr * 65 + c4 + 0] = v[i][0] * sc[i]; T[rr * 65 + c4 + 1] = v[i][1] * sc[i];
        T[rr * 65 + c4 + 2] = v[i][2] * sc[i]; T[rr * 65 + c4 + 3] = v[i][3] * sc[i];
      }
#pragma unroll
      for (int j = 0; j < 8; ++j) {
        const int n = n8 + 8 * j;
        float tt[8];
#pragma unroll
        for (int i = 0; i < 8; ++i) tt[i] = T[(k8 + i) * 65 + n];
        u32x4 pk = {cvtpk(tt[0], tt[1]), cvtpk(tt[2], tt[3]), cvtpk(tt[4], tt[5]), cvtpk(tt[6], tt[7])};
        *(u32x4*)(d.dst + (long)n * d.ld_dst + k8) = pk;
      }
    }
  }
  __syncthreads();
  f32x4* WF = (f32x4*)smem;
  for (int idx = tid; idx < 4096; idx += NTHR) {
    const int ln = idx & 63, half = (idx >> 6) & 1, e = (idx >> 7) & 3, i = idx >> 9;
    const int k = (i * 64 + ln) * 4 + e;
    WF[idx] = *(const f32x4*)(p.w_in + (long)k * NIN + 3072 + half * 4);
  }
  __syncthreads();
  const int row0 = blockIdx.x * 8 + wid, rstride = gridDim.x * 8;
  f32x4 xnA[8], xnB[8];
  {
    const f32x4* xa = (const f32x4*)(p.x + (long)row0 * DM);
    const f32x4* xb = (const f32x4*)(p.x + (long)(row0 + rstride) * DM);
#pragma unroll
    for (int i = 0; i < 8; ++i) { xnA[i] = __builtin_nontemporal_load(xa + i * 64 + lane); xnB[i] = __builtin_nontemporal_load(xb + i * 64 + lane); }
  }
  for (int row = row0; row < MTOK; row += 2 * rstride) {
    const int rowB = row + rstride;
    f32x4 xA[8], xB[8];
#pragma unroll
    for (int i = 0; i < 8; ++i) { xA[i] = xnA[i]; xB[i] = xnB[i]; }
    if (row + 2 * rstride < MTOK) {
      const f32x4* xa = (const f32x4*)(p.x + (long)(row + 2 * rstride) * DM);
      const f32x4* xb = (const f32x4*)(p.x + (long)(row + 3 * rstride) * DM);
#pragma unroll
      for (int i = 0; i < 8; ++i) { xnA[i] = __builtin_nontemporal_load(xa + i * 64 + lane); xnB[i] = __builtin_nontemporal_load(xb + i * 64 + lane); }
    }
    float ssA = 0.f, ssB = 0.f;
#pragma unroll
    for (int i = 0; i < 8; ++i) {
      ssA += xA[i][0] * xA[i][0] + xA[i][1] * xA[i][1] + xA[i][2] * xA[i][2] + xA[i][3] * xA[i][3];
      ssB += xB[i][0] * xB[i][0] + xB[i][1] * xB[i][1] + xB[i][2] * xB[i][2] + xB[i][3] * xB[i][3];
    }
    ssA = wsum(ssA); ssB = wsum(ssB);
    const float rsA = rsqrtf(ssA * (1.f / DM) + EPS), rsB = rsqrtf(ssB * (1.f / DM) + EPS);
    float fA[8], fB[8];
#pragma unroll
    for (int q = 0; q < 8; ++q) { fA[q] = 0.f; fB[q] = 0.f; }
#pragma unroll
    for (int i = 0; i < 8; ++i) {
      f32x4 g = ((const f32x4*)p.norm_g)[i * 64 + lane];
      float hA[4], hB[4];
#pragma unroll
      for (int e = 0; e < 4; ++e) { hA[e] = xA[i][e] * rsA * g[e]; hB[e] = xB[i][e] * rsB * g[e]; }
      u32x2 pkA = {cvtpk(hA[0], hA[1]), cvtpk(hA[2], hA[3])}, pkB = {cvtpk(hB[0], hB[1]), cvtpk(hB[2], hB[3])};
      *(u32x2*)(p.hb + (long)row * DM + (i * 64 + lane) * 4) = pkA;
      *(u32x2*)(p.hb + (long)rowB * DM + (i * 64 + lane) * 4) = pkB;
#pragma unroll
      for (int e = 0; e < 4; ++e) {
        f32x4 wa = WF[((i * 4 + e) * 2 + 0) * 64 + lane], wb = WF[((i * 4 + e) * 2 + 1) * 64 + lane];
        fA[0] += hA[e] * wa[0]; fA[1] += hA[e] * wa[1]; fA[2] += hA[e] * wa[2]; fA[3] += hA[e] * wa[3];
        fA[4] += hA[e] * wb[0]; fA[5] += hA[e] * wb[1]; fA[6] += hA[e] * wb[2]; fA[7] += hA[e] * wb[3];
        fB[0] += hB[e] * wa[0]; fB[1] += hB[e] * wa[1]; fB[2] += hB[e] * wa[2]; fB[3] += hB[e] * wa[3];
        fB[4] += hB[e] * wb[0]; fB[5] += hB[e] * wb[1]; fB[6] += hB[e] * wb[2]; fB[7] += hB[e] * wb[3];
      }
      __builtin_amdgcn_sched_barrier(0);
    }
#pragma unroll
    for (int q = 0; q < 8; ++q) { fA[q] = wsum(fA[q]); fB[q] = wsum(fB[q]); }
    if (lane == 0) {
      const int bA = row / SEQ, sA = row % SEQ, bB = rowB / SEQ, sB = rowB % SEQ;
#pragma unroll
      for (int q = 0; q < 8; ++q) {
        p.logf[(bA * NH + q) * SEQ + sA] = log_sigmoidf_(fA[q] + p.b_f[q]);
        p.logf[(bB * NH + q) * SEQ + sB] = log_sigmoidf_(fB[q] + p.b_f[q]);
      }
    }
  }
  __syncthreads();
}

constexpr int BM = 256, BK = 64, HALF = 128, HT = HALF * BK;
constexpr int SHM_BYTES = 8 * HT * 2;
constexpr int SHM_TOTAL = 8 * 32 * 132 * 4;

__device__ __forceinline__ int lds_byte(int r, int c) {
  int st = (r >> 4) * 2 + (c >> 5), rr = r & 15, cc = c & 31, ob = rr * 64 + cc * 2;
  return st * 1024 + (ob ^ (((ob >> 9) & 1) << 5));
}
__device__ __forceinline__ void stage_rc(int b, int& R, int& C) {
  int st = b / 1024, sb = b % 1024, swz = sb ^ (((sb >> 9) & 1) << 5);
  R = (st >> 1) * 16 + swz / 64; C = (st & 1) * 32 + (swz % 64) / 2;
}

#define SA(b, h) ((u16*)smem + ((b) * 2 + (h)) * HT)
#define SB(b, h) ((u16*)smem + (4 + (b) * 2 + (h)) * HT)
#define STAGE(P, BASE, br, kt) do { const char* _u = (const char*)((BASE) + (long)(br) * KD + (long)(kt) * BK); \
    __builtin_amdgcn_global_load_lds((const unsigned*)(_u + soff0), (unsigned*)((char*)(P) + gtid * 16), 16, 0, 0); \
    __builtin_amdgcn_global_load_lds((const unsigned*)(_u + soff1), (unsigned*)((char*)(P) + gtid * 16 + 8192), 16, 0, 0); } while (0)
#define LDA(dst, b, h) for (int m = 0; m < 4; ++m) for (int k = 0; k < 2; ++k) \
    dst[m][k] = *reinterpret_cast<const bf16x8*>((char*)SA(b, h) + lds_byte(wr * 64 + m * 16 + fr, k * 32 + fq * 8))
#define LDB(dst, b, h) for (int n = 0; n < 2; ++n) for (int k = 0; k < 2; ++k) \
    dst[n][k] = *reinterpret_cast<const bf16x8*>((char*)SB(b, h) + lds_byte(wc * 32 + n * 16 + fr, k * 32 + fq * 8))
#define MMA(ai, bj, At, Bt_) do { __builtin_amdgcn_s_setprio(1); \
    for (int m = 0; m < 4; ++m) for (int n = 0; n < 2; ++n) for (int k = 0; k < 2; ++k) \
      acc[ai][bj][m][n] = __builtin_amdgcn_mfma_f32_16x16x32_bf16(Bt_[n][k], At[m][k], acc[ai][bj][m][n], 0, 0, 0); \
    __builtin_amdgcn_s_setprio(0); } while (0)
#define WAIT_V(n) asm volatile("s_waitcnt vmcnt(" #n ")" ::: "memory")
#define WAIT_L(n) asm volatile("s_waitcnt lgkmcnt(" #n ")" ::: "memory")
#define BAR __builtin_amdgcn_s_barrier()
#define SCHED __builtin_amdgcn_sched_barrier(0)

template <bool MID>
__device__ __forceinline__ void gemm_core(const u16* __restrict__ A, const u16* __restrict__ Bt, const int brow, const int bcol,
                                          f32x4 (&acc)[2][2][4][2], const float* __restrict__ ssq) {
  int gtid = threadIdx.x; asm volatile("" : "+v"(gtid));
  const int wid = gtid >> 6, lane = gtid & 63, wr = wid >> 2, wc = wid & 3, fr = lane & 15, fq = lane >> 4;
  unsigned soff0, soff1;
  { int r_, c_; stage_rc(gtid * 16, r_, c_); soff0 = (unsigned)(r_ * KD + c_) * 2u; stage_rc(gtid * 16 + 8192, r_, c_); soff1 = (unsigned)(r_ * KD + c_) * 2u; }
  bf16x8 At[4][2], B0[2][2], B1[2][2];
  constexpr int nt = KD / BK;
  STAGE(SB(0, 0), Bt, bcol, 0); STAGE(SA(0, 0), A, brow, 0);
  STAGE(SB(0, 1), Bt, bcol + HALF, 0); STAGE(SA(0, 1), A, brow + HALF, 0);
  if (wr == 1) BAR;
  WAIT_V(4); BAR;
  STAGE(SB(1, 0), Bt, bcol, 1); STAGE(SA(1, 0), A, brow, 1); STAGE(SB(1, 1), Bt, bcol + HALF, 1);
  WAIT_V(6); BAR;
  for (int t = 0; t < nt - 2; t += 2) {
    if (MID && t == 16) {
      const float* rt_ = (const float*)(smem + SHM_BYTES);
#pragma unroll
      for (int ai = 0; ai < 2; ++ai)
#pragma unroll
        for (int m = 0; m < 4; ++m) {
          const float ratio = rt_[ai * HALF + wr * 64 + m * 16 + fr];
#pragma unroll
          for (int bj = 0; bj < 2; ++bj)
#pragma unroll
            for (int n = 0; n < 2; ++n)
#pragma unroll
              for (int j = 0; j < 4; ++j) acc[ai][bj][m][n][j] *= ratio;
        }
    }
    LDB(B0, 0, 0); SCHED; LDA(At, 0, 0); STAGE(SA(1, 1), A, brow + HALF, t + 1);
    WAIT_L(8); BAR; WAIT_L(0); MMA(0, 0, At, B0); BAR; SCHED;
    LDB(B1, 0, 1); STAGE(SB(0, 0), Bt, bcol, t + 2);
    BAR; WAIT_L(0); MMA(0, 1, At, B1); BAR;
    LDA(At, 0, 1); STAGE(SA(0, 0), A, brow, t + 2);
    BAR; WAIT_L(0); MMA(1, 0, At, B0); BAR; SCHED;
    STAGE(SB(0, 1), Bt, bcol + HALF, t + 2);
    WAIT_V(6); BAR; MMA(1, 1, At, B1); BAR;
    LDB(B0, 1, 0); SCHED; LDA(At, 1, 0); STAGE(SA(0, 1), A, brow + HALF, t + 2);
    WAIT_L(8); BAR; WAIT_L(0); MMA(0, 0, At, B0); BAR; SCHED;
    LDB(B1, 1, 1); STAGE(SB(1, 0), Bt, bcol, t + 3);
    BAR; WAIT_L(0); MMA(0, 1, At, B1); BAR;
    LDA(At, 1, 1); STAGE(SA(1, 0), A, brow, t + 3);
    BAR; WAIT_L(0); MMA(1, 0, At, B0); BAR; SCHED;
    STAGE(SB(1, 1), Bt, bcol + HALF, t + 3);
    WAIT_V(6); BAR; MMA(1, 1, At, B1); BAR;
  }
  { LDB(B0, 0, 0); LDA(At, 0, 0); STAGE(SA(1, 1), A, brow + HALF, nt - 1);
    BAR; WAIT_L(0); MMA(0, 0, At, B0); BAR;
    LDB(B1, 0, 1); BAR; WAIT_L(0); MMA(0, 1, At, B1); BAR;
    LDA(At, 0, 1); WAIT_V(4); BAR; WAIT_L(0); MMA(1, 0, At, B0); MMA(1, 1, At, B1); BAR; }
  { LDB(B0, 1, 0); LDA(At, 1, 0); WAIT_V(2); BAR; WAIT_L(0); MMA(0, 0, At, B0); BAR;
    LDB(B1, 1, 1); WAIT_V(0); BAR; WAIT_L(0); MMA(0, 1, At, B1); BAR;
    LDA(At, 1, 1); BAR; WAIT_L(0); MMA(1, 0, At, B0); MMA(1, 1, At, B1); BAR; }
  if (wr == 0) BAR;
}

__device__ __forceinline__ void tile_map(int round, int nPatchN, int& pm, int& pn) {
  const int xcd = blockIdx.x & 7, local = blockIdx.x >> 3;
  const int patch = round * 8 + xcd;
  const int pmm = patch / nPatchN, pnn = patch % nPatchN;
  pm = pmm * 4 + (local & 3); pn = pnn * 8 + (local >> 2);
}

__device__ void phase_inproj(const Params& p) {
  for (int round = 0; round < 6; ++round) {
    int pm, pn; tile_map(round, 3, pm, pn);
    const int brow = pm * BM, bcol = pn * BM;
    f32x4 acc[2][2][4][2] = {};
    gemm_core<false>(p.hb, p.WinT, brow, bcol, acc, nullptr);
    __syncthreads();
    int tid = threadIdx.x; asm volatile("" : "+v"(tid));
    const int wid = tid >> 6, lane = tid & 63, wr = wid >> 2, wc = wid & 3, fr = lane & 15, fq = lane >> 4;
    const int region = pn >> 2;
    const int cofs = (pn & 3) * 256;
    const float osc = (region == 0) ? QSCALE : 1.f;
    u16* C16 = (u16*)smem;
    float kn2 = 0.f;
#pragma unroll
    for (int ai = 0; ai < 2; ++ai) {
      if (region != 2) {
#pragma unroll
        for (int bj = 0; bj < 2; ++bj)
#pragma unroll
          for (int m = 0; m < 4; ++m)
#pragma unroll
            for (int n = 0; n < 2; ++n) {
              const int r = wr * 64 + m * 16 + fr, c = bj * 128 + wc * 32 + n * 16 + fq * 4;
              u32x2 pk = {cvtpk(acc[ai][bj][m][n][0] * osc, acc[ai][bj][m][n][1] * osc), cvtpk(acc[ai][bj][m][n][2] * osc, acc[ai][bj][m][n][3] * osc)};
              *(u32x2*)(C16 + r * 264 + c) = pk;
            }
        __syncthreads();
        u16* dst = (region == 0) ? p.qb : (region == 1) ? p.kb : (region == 3) ? p.za : (region == 4) ? p.xl : p.zl;
#pragma unroll
        for (int i = 0; i < 8; ++i) {
          const int id = tid + NTHR * i, r = id >> 5, c8 = (id & 31) * 8;
          u32x4 v = *(const u32x4*)(C16 + r * 264 + c8);
          *(u32x4*)(dst + (long)(brow + ai * HALF + r) * 1024 + cofs + c8) = v;
          if (region == 1) {
            float s2 = 0.f;
#pragma unroll
            for (int e = 0; e < 4; ++e) { const float a = bflo(v[e]), bq = bfhi(v[e]); s2 += a * a + bq * bq; }
            s2 += __shfl_xor(s2, 1); s2 += __shfl_xor(s2, 2); s2 += __shfl_xor(s2, 4); s2 += __shfl_xor(s2, 8);
            kn2 = fmaxf(kn2, s2);
          }
        }
      } else {
#pragma unroll
        for (int bj = 0; bj < 2; ++bj)
#pragma unroll
          for (int m = 0; m < 4; ++m)
#pragma unroll
            for (int n = 0; n < 2; ++n) {
              const int r = wr * 64 + m * 16 + fr, c = bj * 128 + wc * 32 + n * 16 + fq * 4;
#pragma unroll
              for (int j = 0; j < 4; ++j) C16[(c + j) * 136 + r] = (u16)cvtpk(acc[ai][bj][m][n][j], 0.f);
            }
        __syncthreads();
        const int b = brow / SEQ, s0 = brow % SEQ + ai * HALF;
#pragma unroll
        for (int i = 0; i < 8; ++i) {
          const int id = tid + NTHR * i, c = id >> 4, r8 = (id & 15) * 8;
          u32x4 v = *(const u32x4*)(C16 + c * 136 + r8);
          const int head = (pn & 3) * 2 + (c >> 7), d = c & 127;
          *(u32x4*)(p.vT + ((long)(b * NH + head) * HD + d) * SEQ + s0 + r8) = v;
        }
      }
      __syncthreads();
    }
    if (region == 1) {
      kn2 = fmaxf(kn2, __shfl_xor(kn2, 32));
      if ((lane & 47) == 0)
        atomicMax((unsigned*)p.ssq + 3 * MTOK + (brow / SEQ) * NH + (pn & 3) * 2 + ((lane >> 4) & 1), __float_as_uint(kn2));
    }
  }
}

__device__ void cumsum_item(const Params& p, int bh) {
  int tid = threadIdx.x; asm volatile("" : "+v"(tid));
  const int lane = tid & 63, wid = tid >> 6;
  float* wtot = (float*)smem;
  const float* src = p.logf + bh * SEQ + tid * 16;
  float v[16];
#pragma unroll
  for (int i = 0; i < 4; ++i) { f32x4 t = *(const f32x4*)(src + i * 4); v[i * 4] = t[0]; v[i * 4 + 1] = t[1]; v[i * 4 + 2] = t[2]; v[i * 4 + 3] = t[3]; }
#pragma unroll
  for (int i = 1; i < 16; ++i) v[i] += v[i - 1];
  float tot = v[15], inc = tot;
#pragma unroll
  for (int o = 1; o < 64; o <<= 1) { float u = __shfl_up(inc, o); if (lane >= o) inc += u; }
  if (lane == 63) wtot[wid] = inc;
  __syncthreads();
  float base = inc - tot;
  for (int w = 0; w < wid; ++w) base += wtot[w];
  float* dst = p.c2 + bh * SEQ + tid * 16;
#pragma unroll
  for (int i = 0; i < 4; ++i) {
    f32x4 t = {(v[i * 4] + base) * LOG2E, (v[i * 4 + 1] + base) * LOG2E, (v[i * 4 + 2] + base) * LOG2E, (v[i * 4 + 3] + base) * LOG2E};
    *(f32x4*)(dst + i * 4) = t;
  }
  __syncthreads();
}

template <int PASS>
__device__ void lru_phase(const Params& p) {
  int tid = threadIdx.x; asm volatile("" : "+v"(tid));
  const int lane = tid & 63, w = tid >> 6, fr = lane & 15, fq = lane >> 4;
  const int nb = blockIdx.x & 7, c0 = blockIdx.x >> 3;
  u16* Ub = (u16*)smem;
  float* U32 = (float*)(smem + 17408);
  float* Ab = (float*)(smem + 50176);
  float* Bb = (float*)(smem + 82944);
  float* sgA = (float*)(smem + 115712);
  float* sgH = sgA + 512;
  const float* CY = (const float*)(smem + 126976);
  bf16x8 bR[4], bI[4];
  {
    const u16* wr_ = p.WgT + (long)nb * 16384 + (w * 16 + fr) * 128 + fq * 8;
    const u16* wi_ = p.WgT + (long)(8 + nb) * 16384 + (w * 16 + fr) * 128 + fq * 8;
#pragma unroll
    for (int ks = 0; ks < 4; ++ks) { bR[ks] = *(const bf16x8*)(wr_ + ks * 32); bI[ks] = *(const bf16x8*)(wi_ + ks * 32); }
  }
  const int c8 = (tid & 15) * 8, tr = tid >> 4, gc = nb * 128 + c8;
  float cw[4][8], cb[8];
#pragma unroll
  for (int k = 0; k < 4; ++k) {
    f32x4 a = *(const f32x4*)(p.conv_w + k * LW + gc), bq = *(const f32x4*)(p.conv_w + k * LW + gc + 4);
    cw[k][0] = a[0]; cw[k][1] = a[1]; cw[k][2] = a[2]; cw[k][3] = a[3]; cw[k][4] = bq[0]; cw[k][5] = bq[1]; cw[k][6] = bq[2]; cw[k][7] = bq[3];
  }
  { f32x4 a = *(const f32x4*)(p.conv_b + gc), bq = *(const f32x4*)(p.conv_b + gc + 4);
    cb[0] = a[0]; cb[1] = a[1]; cb[2] = a[2]; cb[3] = a[3]; cb[4] = bq[0]; cb[5] = bq[1]; cb[6] = bq[2]; cb[7] = bq[3]; }
  const int chE = w * 16 + fr, gchE = nb * 128 + chE;
  const float br = p.b_rg[gchE], bi = p.b_ig[gchE];
  const float sp = log1pf(__expf(-p.lam[gchE]));
  const int ch = tid & 127, seg = tid >> 7;
  const int to = tid >> 3, c16 = (tid & 7) * 16;
  u32x4 xr[2][4];
#define LRU_PREFETCH(i_) do { const int b_ = (i_) >> 2, s0_ = (c0 + 32 * ((i_) & 3)) * CHUNK; const long tokb_ = (long)b_ * SEQ; \
    _Pragma("unroll") for (int tt = 0; tt < 2; ++tt) _Pragma("unroll") for (int k = 0; k < 4; ++k) { \
      const int sp_ = s0_ + tr + tt * 32 - 3 + k; u32x4 z_ = {0u, 0u, 0u, 0u}; \
      xr[tt][k] = (sp_ >= 0) ? __builtin_nontemporal_load((const u32x4*)(p.xl + (tokb_ + sp_) * LW + gc)) : z_; } \
    } while (0)
  LRU_PREFETCH(0);
#pragma unroll 1
  for (int it = 0; it < 8; ++it) {
    const int b = it >> 2, chunk = c0 + 32 * (it & 3), s0 = chunk * CHUNK;
    const long tokb = (long)b * SEQ;
    u32x4 z0, z1;
    if (PASS == 2) { const u16* zp_ = p.zl + (tokb + s0 + to) * LW + nb * 128 + c16; z0 = __builtin_nontemporal_load((const u32x4*)zp_); z1 = __builtin_nontemporal_load((const u32x4*)(zp_ + 8)); }
#pragma unroll
    for (int tt = 0; tt < 2; ++tt) {
      const int t = tr + tt * 32;
      f2_t u2[4];
#pragma unroll
      for (int e = 0; e < 4; ++e) { f2_t c_ = {cb[2 * e], cb[2 * e + 1]}; u2[e] = c_; }
#pragma unroll
      for (int k = 0; k < 4; ++k)
#pragma unroll
        for (int e = 0; e < 4; ++e) {
          f2_t w_ = {cw[k][2 * e], cw[k][2 * e + 1]}, x_ = {bflo(xr[tt][k][e]), bfhi(xr[tt][k][e])};
          u2[e] = w_ * x_ + u2[e];
        }
      f32x4 u0 = {u2[0][0], u2[0][1], u2[1][0], u2[1][1]}, u1 = {u2[2][0], u2[2][1], u2[3][0], u2[3][1]};
      *(f32x4*)(U32 + t * 128 + c8) = u0; *(f32x4*)(U32 + t * 128 + c8 + 4) = u1;
      u32x4 pk = {cvtpk(u2[0][0], u2[0][1]), cvtpk(u2[1][0], u2[1][1]), cvtpk(u2[2][0], u2[2][1]), cvtpk(u2[3][0], u2[3][1])};
      *(u32x4*)(Ub + t * 136 + c8) = pk;
    }
    if (it + 1 < 8) LRU_PREFETCH(it + 1);
    __syncthreads();
    f32x4 aR[4] = {}, aI[4] = {};
    {
      bf16x8 af[4];
#define ALD(i) af[(i) & 3] = *(const bf16x8*)(Ub + (((i) & 3) * 16 + fr) * 136 + ((i) >> 2) * 32 + fq * 8)
      ALD(0); ALD(1); ALD(2);
#pragma unroll
      for (int i = 0; i < 16; ++i) {
        if (i + 3 < 16) ALD(i + 3);
        aR[i & 3] = __builtin_amdgcn_mfma_f32_16x16x32_bf16(af[i & 3], bR[i >> 2], aR[i & 3], 0, 0, 0);
        aI[i & 3] = __builtin_amdgcn_mfma_f32_16x16x32_bf16(af[i & 3], bI[i >> 2], aI[i & 3], 0, 0, 0);
        __builtin_amdgcn_sched_barrier(0);
      }
#undef ALD
    }
    {
      const f2_t nl2 = {-LOG2E, -LOG2E}, one = {1.f, 1.f};
      const f2_t brs = {br * -LOG2E, br * -LOG2E}, bis = {bi * -LOG2E, bi * -LOG2E};
      const float c1s = -8.f * sp * LOG2E;
      const f2_t c1 = {c1s, c1s};
#pragma unroll
      for (int m = 0; m < 4; ++m)
#pragma unroll
        for (int j = 0; j < 4; j += 2) {
          const int t = m * 16 + fq * 4 + j;
          f2_t xr2 = {aR[m][j], aR[m][j + 1]}, xi2 = {aI[m][j], aI[m][j + 1]};
          f2_t tr2 = xr2 * nl2 + brs, ti2 = xi2 * nl2 + bis;
          f2_t e1 = {__builtin_amdgcn_exp2f(tr2[0]), __builtin_amdgcn_exp2f(tr2[1])};
          f2_t e2 = {__builtin_amdgcn_exp2f(ti2[0]), __builtin_amdgcn_exp2f(ti2[1])};
          f2_t d1 = e1 + one, d2 = e2 + one;
          f2_t r2 = {__builtin_amdgcn_rcpf(d1[0]), __builtin_amdgcn_rcpf(d1[1])};
          f2_t ig2 = {__builtin_amdgcn_rcpf(d2[0]), __builtin_amdgcn_rcpf(d2[1])};
          f2_t ta = r2 * c1;
          f2_t a2 = {__builtin_amdgcn_exp2f(ta[0]), __builtin_amdgcn_exp2f(ta[1])};
          f2_t om = one - a2 * a2;
          f2_t mu = {__builtin_amdgcn_sqrtf(om[0]), __builtin_amdgcn_sqrtf(om[1])};
          f2_t uu = {U32[t * 128 + chE], U32[(t + 1) * 128 + chE]};
          f2_t bt = mu * ig2 * uu;
          Ab[t * 128 + chE] = a2[0]; Ab[(t + 1) * 128 + chE] = a2[1];
          Bb[t * 128 + chE] = bt[0]; Bb[(t + 1) * 128 + chE] = bt[1];
        }
    }
    __syncthreads();
    {
      float A = 1.f, H = 0.f;
#pragma unroll
      for (int i = 0; i < 16; ++i) { const int t = seg * 16 + i; const float a = Ab[t * 128 + ch]; H = a * H + Bb[t * 128 + ch]; A *= a; }
      sgA[seg * 128 + ch] = A; sgH[seg * 128 + ch] = H;
    }
    __syncthreads();
    if (PASS == 1) {
      if (tid < 128) {
        float A = 1.f, H = 0.f;
#pragma unroll
        for (int s = 0; s < 4; ++s) { const float a = sgA[s * 128 + ch]; H = a * H + sgH[s * 128 + ch]; A *= a; }
        const unsigned oi = (unsigned)((b * NCHUNK + chunk) * LW + nb * 128 + ch);
        p.lruA[oi] = A;
        p.lruH[oi] = H;
      }
    } else {
      float H = CY[it * 128 + ch];
#pragma unroll
      for (int s = 0; s < 3; ++s) if (s < seg) H = sgA[s * 128 + ch] * H + sgH[s * 128 + ch];
#pragma unroll
      for (int i = 0; i < 16; ++i) { const int t = seg * 16 + i; H = Ab[t * 128 + ch] * H + Bb[t * 128 + ch]; Bb[t * 128 + ch] = H; }
      __syncthreads();
      const long tok = tokb + s0 + to;
      float h[16], ss = 0.f;
#pragma unroll
      for (int i = 0; i < 4; ++i) { f32x4 v = *(const f32x4*)(Bb + to * 128 + c16 + i * 4); h[i * 4] = v[0]; h[i * 4 + 1] = v[1]; h[i * 4 + 2] = v[2]; h[i * 4 + 3] = v[3]; }
#pragma unroll
      for (int i = 0; i < 16; ++i) ss += h[i] * h[i];
      ss += __shfl_xor(ss, 1); ss += __shfl_xor(ss, 2); ss += __shfl_xor(ss, 4);
      if ((tid & 7) == 0) atomicAdd(p.ssq + MTOK + tok, ss);
      unsigned o[8];
#pragma unroll
      for (int i = 0; i < 8; ++i) {
        const unsigned zw = (i < 4) ? z0[i & 3] : z1[i & 3];
        const f2_t z2 = {bflo(zw), bfhi(zw)}, h2 = {h[2 * i], h[2 * i + 1]}, nl2 = {-LOG2E, -LOG2E}, one = {1.f, 1.f};
        const f2_t t2 = z2 * nl2;
        const f2_t e2 = {__builtin_amdgcn_exp2f(t2[0]), __builtin_amdgcn_exp2f(t2[1])};
        const f2_t d2 = e2 + one;
        const f2_t iv = {__builtin_amdgcn_rcpf(d2[0]), __builtin_amdgcn_rcpf(d2[1])};
        const f2_t ov = h2 * z2 * iv;
        o[i] = cvtpk(ov[0], ov[1]);
      }
      u16* op = p.mixed + tok * DM + AW + nb * 128 + c16;
      u32x4 o0 = {o[0], o[1], o[2], o[3]}, o1 = {o[4], o[5], o[6], o[7]};
      *(u32x4*)op = o0; *(u32x4*)(op + 8) = o1;
    }
  }
  __syncthreads();
#undef LRU_PREFETCH
}

__device__ void lru_carry_block(const Params& p) {
  float* CY = (float*)(smem + 126976);
  float* TA = (float*)smem;
  float* TH = TA + 512;
  int tid = threadIdx.x; asm volatile("" : "+v"(tid));
  const int ch = tid & 127, sg = tid >> 7;
  const int nb = blockIdx.x & 7, c0 = blockIdx.x >> 3;
  const int lo = (sg == 0) ? 0 : c0 + 32 * (sg - 1), hi = c0 + 32 * sg;
  float av[NB][32], hv[NB][32];
#pragma unroll
  for (int b = 0; b < NB; ++b) {
    const float* pa = p.lruA + ((long)b * NCHUNK) * LW + nb * 128 + ch;
    const float* ph = p.lruH + ((long)b * NCHUNK) * LW + nb * 128 + ch;
#pragma unroll
    for (int u = 0; u < 32; ++u) {
      const int c = lo + u;
      const bool ok = c < hi;
      av[b][u] = ok ? pa[(long)c * LW] : 1.f;
      hv[b][u] = ok ? ph[(long)c * LW] : 0.f;
    }
  }
#pragma unroll
  for (int b = 0; b < NB; ++b) {
    float A = 1.f, H = 0.f;
#pragma unroll
    for (int u = 0; u < 32; ++u) { H = av[b][u] * H + hv[b][u]; A *= av[b][u]; }
    TA[sg * 128 + ch] = A; TH[sg * 128 + ch] = H;
    __syncthreads();
    if (tid < 128) {
      float Hc = 0.f;
#pragma unroll
      for (int i = 0; i < 4; ++i) { Hc = TA[i * 128 + ch] * Hc + TH[i * 128 + ch]; CY[(b * 4 + i) * 128 + ch] = Hc; }
    }
    __syncthreads();
  }
}

__device__ void attn_item(const Params& p, int b, int h, int qblk) {
  int tid = threadIdx.x; asm volatile("" : "+v"(tid));
  const int lane = tid & 63, w = tid >> 6, c = lane & 31, hi = lane >> 5;
  char* Kl = smem;
  char* Vl = smem + 34816;
  float* Cl = (float*)(smem + 69632);
  const int P0 = qblk * 256;
  const int qrow = P0 + w * 32 + c;
  const long tokb = (long)b * SEQ;
  const int bh = b * NH + h;
  bf16x8 qf[8];
  {
    const u16* qp = p.qb + (tokb + qrow) * AW + h * HD + hi * 8;
#pragma unroll
    for (int d0 = 0; d0 < 8; ++d0) qf[d0] = *(const bf16x8*)(qp + d0 * 16);
  }
  const float* c2 = p.c2 + (long)bh * SEQ;
  float* Wm = (float*)(smem + 69632 + 512);
  float ebase;
  {
    float q2 = 0.f;
#pragma unroll
    for (int d0 = 0; d0 < 8; ++d0) {
      u32x4 t = __builtin_bit_cast(u32x4, qf[d0]);
#pragma unroll
      for (int e = 0; e < 4; ++e) { const float a = bflo(t[e]), bq = bfhi(t[e]); q2 += a * a + bq * bq; }
    }
    q2 = xh_sum(q2);
    const float kmax = sqrtf(__uint_as_float(((const unsigned*)p.ssq)[3 * MTOK + bh])) * 1.001f;
    ebase = sqrtf(q2) * 1.001f * kmax;
  }
  constexpr float T2 = 40.f;
  f32x16 o[4];
#pragma unroll
  for (int dt = 0; dt < 4; ++dt)
#pragma unroll
    for (int r = 0; r < 16; ++r) o[dt][r] = 0.f;
  float mrun = -1e30f, lrun = 0.f, ewave = __builtin_inff();
  const int jhi = 4 * qblk + 3;
  const int kkey = tid >> 3, kc = (tid & 7) * 16;
  const int vd = tid >> 2, vk = (tid & 3) * 16;
  const u16* kg = p.kb + (tokb + kkey) * AW + h * HD + kc;
  const u16* vg = p.vT + ((long)bh * HD + vd) * SEQ + vk;
  u32x4 sk0A, sk1A, sv0A, sv1A, sk0B, sk1B, sv0B, sv1B; float scA = 0.f, scB = 0.f;
#define AT_GLOAD(S, j) do { const u16* kp_ = kg + (long)(j) * 64 * AW; sk0##S = *(const u32x4*)kp_; sk1##S = *(const u32x4*)(kp_ + 8); \
    const u16* vp_ = vg + (j) * 64; sv0##S = *(const u32x4*)vp_; sv1##S = *(const u32x4*)(vp_ + 8); if (tid < 64) sc##S = c2[(j) * 64 + tid]; } while (0)
#define AT_LSTORE(S, bf) do { char* kd_ = Kl + (bf) * 17408 + kkey * 272 + kc * 2; *(u32x4*)kd_ = sk0##S; *(u32x4*)(kd_ + 16) = sk1##S; \
    char* vd_ = Vl + (bf) * 17408 + vd * 136 + vk * 2; u32x2 a0_ = {sv0##S[0], sv0##S[1]}, a1_ = {sv0##S[2], sv0##S[3]}, a2_ = {sv1##S[0], sv1##S[1]}, a3_ = {sv1##S[2], sv1##S[3]}; \
    *(u32x2*)vd_ = a0_; *(u32x2*)(vd_ + 8) = a1_; *(u32x2*)(vd_ + 16) = a2_; *(u32x2*)(vd_ + 24) = a3_; if (tid < 64) Cl[(bf) * 64 + tid] = -sc##S; } while (0)
  AT_GLOAD(A, jhi);
  AT_GLOAD(B, jhi - 1);
  AT_LSTORE(A, 0);
  AT_GLOAD(A, jhi - 2);
  __syncthreads();
  auto tile_body = [&](const int buf, const int j, const int it) __attribute__((always_inline)) {
    const int k0 = 64 * j;
    if (k0 <= P0 + w * 32 + 31 && !(ewave + Cl[buf * 64 + 63] <= -T2)) {
      f32x16 p0, p1;
      {
        const float* ck = Cl + buf * 64 + 4 * hi;
#pragma unroll
        for (int g = 0; g < 4; ++g) {
          f32x4 v0 = *(const f32x4*)(ck + 8 * g), v1 = *(const f32x4*)(ck + 32 + 8 * g);
#pragma unroll
          for (int e = 0; e < 4; ++e) { p0[4 * g + e] = v0[e]; p1[4 * g + e] = v1[e]; }
        }
      }
      const char* kb_ = Kl + buf * 17408 + c * 272 + hi * 16;
      {
        bf16x8 kf[4][2];
#define KLD(d) do { kf[(d) & 3][0] = *(const bf16x8*)(kb_ + (d) * 32); kf[(d) & 3][1] = *(const bf16x8*)(kb_ + 32 * 272 + (d) * 32); } while (0)
        KLD(0); KLD(1); KLD(2);
#pragma unroll
        for (int d0 = 0; d0 < 8; ++d0) {
          if (d0 + 3 < 8) KLD(d0 + 3);
          p0 = __builtin_amdgcn_mfma_f32_32x32x16_bf16(kf[d0 & 3][0], qf[d0], p0, 0, 0, 0);
          p1 = __builtin_amdgcn_mfma_f32_32x32x16_bf16(kf[d0 & 3][1], qf[d0], p1, 0, 0, 0);
          __builtin_amdgcn_sched_barrier(0);
        }
#undef KLD
      }
      if (k0 + 63 > P0 + w * 32) {
        const float NEG = -__builtin_inff();
#pragma unroll
        for (int r = 0; r < 16; ++r) {
          const int key = k0 + (r & 3) + 8 * (r >> 2) + 4 * hi;
          if (key > qrow) p0[r] = NEG;
          if (key + 32 > qrow) p1[r] = NEG;
        }
      }
      float mx;
      {
        f32x16 mv = __builtin_elementwise_max(p0, p1);
        float m8[8];
#pragma unroll
        for (int r = 0; r < 8; ++r) m8[r] = fmaxf(mv[r], mv[r + 8]);
        mx = fmaxf(fmaxf(fmaxf(m8[0], m8[1]), fmaxf(m8[2], m8[3])), fmaxf(fmaxf(m8[4], m8[5]), fmaxf(m8[6], m8[7])));
      }
      mx = xh_max(mx);
      const float mn = fmaxf(mrun, mx);
      const float alpha = __builtin_amdgcn_exp2f(mrun - mn);
      mrun = mn;
      const bool moved = !__all(alpha == 1.f);
      if (moved) {
        float e = ebase - mn;
        e = fmaxf(e, __shfl_xor(e, 16)); e = fmaxf(e, __shfl_xor(e, 8)); e = fmaxf(e, __shfl_xor(e, 4));
        e = fmaxf(e, __shfl_xor(e, 2)); e = fmaxf(e, __shfl_xor(e, 1));
        ewave = e;
      }
      float ps;
      {
        p0 = p0 - mn; p1 = p1 - mn;
#pragma unroll
        for (int r = 0; r < 16; ++r) { p0[r] = __builtin_amdgcn_exp2f(p0[r]); p1[r] = __builtin_amdgcn_exp2f(p1[r]); }
        f32x16 sv = p0 + p1;
        f2_t s2 = {0.f, 0.f};
#pragma unroll
        for (int r = 0; r < 16; r += 2) { f2_t t_ = {sv[r], sv[r + 1]}; s2 += t_; }
        ps = s2[0] + s2[1];
      }
      ps = xh_sum(ps);
      lrun = lrun * alpha + ps;
      if (moved) {
#pragma unroll
        for (int dt = 0; dt < 4; ++dt)
#pragma unroll
          for (int r = 0; r < 16; ++r) o[dt][r] *= alpha;
      }
      bf16x8 pb[4];
      { u32x4 t0 = {cvtpk(p0[0], p0[1]), cvtpk(p0[2], p0[3]), cvtpk(p0[4], p0[5]), cvtpk(p0[6], p0[7])};
        u32x4 t1 = {cvtpk(p0[8], p0[9]), cvtpk(p0[10], p0[11]), cvtpk(p0[12], p0[13]), cvtpk(p0[14], p0[15])};
        u32x4 t2 = {cvtpk(p1[0], p1[1]), cvtpk(p1[2], p1[3]), cvtpk(p1[4], p1[5]), cvtpk(p1[6], p1[7])};
        u32x4 t3 = {cvtpk(p1[8], p1[9]), cvtpk(p1[10], p1[11]), cvtpk(p1[12], p1[13]), cvtpk(p1[14], p1[15])};
        pb[0] = __builtin_bit_cast(bf16x8, t0); pb[1] = __builtin_bit_cast(bf16x8, t1);
        pb[2] = __builtin_bit_cast(bf16x8, t2); pb[3] = __builtin_bit_cast(bf16x8, t3); }
      const char* vb_ = Vl + buf * 17408 + c * 136 + hi * 8;
      {
        u32x4 vv[4];
#define VLD(i) do { const char* a_ = vb_ + ((i) & 3) * 4352 + ((i) >> 2) * 32; u32x2 lo_ = *(const u32x2*)a_, hh_ = *(const u32x2*)(a_ + 16); \
          u32x4 t_ = {lo_[0], lo_[1], hh_[0], hh_[1]}; vv[(i) & 3] = t_; } while (0)
        VLD(0); VLD(1); VLD(2);
#pragma unroll
        for (int i = 0; i < 16; ++i) {
          if (i + 3 < 16) VLD(i + 3);
          o[i & 3] = __builtin_amdgcn_mfma_f32_32x32x16_bf16(__builtin_bit_cast(bf16x8, vv[i & 3]), pb[i >> 2], o[i & 3], 0, 0, 0);
          __builtin_amdgcn_sched_barrier(0);
        }
#undef VLD
      }
    }
    if (lane == 0 && k0 <= P0 + w * 32 + 31) Wm[(it & 1) * 8 + w] = ewave;
  };
#define AT_EXIT(buf_, it_) ((it_) >= 4 && ({ const float* wm = Wm + (((it_) - 1) & 1) * 8; \
      fmaxf(fmaxf(fmaxf(wm[0], wm[1]), fmaxf(wm[2], wm[3])), fmaxf(fmaxf(wm[4], wm[5]), fmaxf(wm[6], wm[7]))); }) + Cl[(buf_) * 64 + 63] <= -T2)
  int it = 0, j = jhi;
  for (;;) {
    if (AT_EXIT(0, it)) break;
    if (j > 0) AT_LSTORE(B, 1);
    if (j > 2) AT_GLOAD(B, j - 3);
    tile_body(0, j, it);
    __syncthreads();
    --j; ++it;
    if (j < 0) break;
    if (AT_EXIT(1, it)) break;
    if (j > 0) AT_LSTORE(A, 0);
    if (j > 2) AT_GLOAD(A, j - 3);
    tile_body(1, j, it);
    __syncthreads();
    --j; ++it;
    if (j < 0) break;
  }
#undef AT_EXIT
#undef AT_GLOAD
#undef AT_LSTORE
  u32x4 zz8[8];
#pragma unroll
  for (int i = 0; i < 8; ++i) {
    const int id = lane + 64 * i, row = id >> 4, d8 = (id & 15) * 8;
    zz8[i] = __builtin_nontemporal_load((const u32x4*)(p.za + (tokb + P0 + w * 32 + row) * AW + h * HD + d8));
  }
  __builtin_amdgcn_sched_barrier(0);
  const float inv = 1.f / lrun;
  float ss = 0.f;
#pragma unroll
  for (int dt = 0; dt < 4; ++dt)
#pragma unroll
    for (int r = 0; r < 16; ++r) { o[dt][r] *= inv; ss += o[dt][r] * o[dt][r]; }
  ss = xh_sum(ss);
  __syncthreads();
  float* Ot = (float*)smem + w * (32 * 132);
#pragma unroll
  for (int dt = 0; dt < 4; ++dt)
#pragma unroll
    for (int g = 0; g < 4; ++g) {
      f32x4 v = {o[dt][4 * g], o[dt][4 * g + 1], o[dt][4 * g + 2], o[dt][4 * g + 3]};
      *(f32x4*)(Ot + c * 132 + dt * 32 + 8 * g + 4 * hi) = v;
    }
#pragma unroll
  for (int i = 0; i < 8; ++i) {
    const int id = lane + 64 * i, row = id >> 4, d8 = (id & 15) * 8;
    const long tr = tokb + P0 + w * 32 + row;
    const u32x4 zz = zz8[i];
    f32x4 a0 = *(const f32x4*)(Ot + row * 132 + d8), a1 = *(const f32x4*)(Ot + row * 132 + d8 + 4);
    u32x4 ov = {cvtpk(a0[0] * siluf_(bflo(zz[0])), a0[1] * siluf_(bfhi(zz[0]))), cvtpk(a0[2] * siluf_(bflo(zz[1])), a0[3] * siluf_(bfhi(zz[1]))),
                cvtpk(a1[0] * siluf_(bflo(zz[2])), a1[1] * siluf_(bfhi(zz[2]))), cvtpk(a1[2] * siluf_(bflo(zz[3])), a1[3] * siluf_(bfhi(zz[3])))};
    *(u32x4*)(p.mixed + tr * DM + h * HD + d8) = ov;
  }
  if (hi == 0) atomicAdd(p.ssq + tokb + qrow, ss);
}

__device__ void phase_outproj(const Params& p) {
  for (int round = 0; round < 2; ++round) {
    int pm, pn; tile_map(round, 1, pm, pn);
    const int brow = pm * BM, bcol = pn * BM;
    f32x4 acc[2][2][4][2] = {};
    {
      const int t_ = threadIdx.x;
      if (t_ < BM) {
        const float ra = __builtin_amdgcn_rsqf(p.ssq[brow + t_] * (1.f / AW) + EPS), rl = __builtin_amdgcn_rsqf(p.ssq[MTOK + brow + t_] * (1.f / LW) + EPS);
        ((float*)(smem + SHM_BYTES))[t_] = ra * __builtin_amdgcn_rcpf(rl);
      }
    }
    gemm_core<true>(p.mixed, p.WoutT, brow, bcol, acc, p.ssq);
    __syncthreads();
    int tid = threadIdx.x; asm volatile("" : "+v"(tid));
    const int wid = tid >> 6, lane = tid & 63, wr = wid >> 2, wc = wid & 3, fr = lane & 15, fq = lane >> 4;
    const int rg = lane >> 4, l16 = lane & 15;
    float* C32 = (float*)smem;
    f32x4 y[2][4][4];
#define XLOAD(ai) do { _Pragma("unroll") for (int i = 0; i < 4; ++i) { const unsigned grow = brow + (ai) * HALF + i * 32 + wid * 4 + rg; \
      const unsigned xo = grow * DM + bcol + l16 * 4; \
      _Pragma("unroll") for (int k = 0; k < 4; ++k) y[ai][i][k] = __builtin_nontemporal_load((const f32x4*)(p.x + xo + 64 * k)); } } while (0)
#define CSTAGE(ai) do { _Pragma("unroll") for (int bj = 0; bj < 2; ++bj) _Pragma("unroll") for (int m = 0; m < 4; ++m) \
      _Pragma("unroll") for (int n = 0; n < 2; ++n) { \
        const int r = wr * 64 + m * 16 + fr, c = bj * 128 + wc * 32 + n * 16 + fq * 4; \
        *(f32x4*)(C32 + r * 256 + (c ^ (fr << 2))) = acc[ai][bj][m][n]; } } while (0)
#define YCOMB(ai) do { float sq_[4]; _Pragma("unroll") for (int i = 0; i < 4; ++i) sq_[i] = p.ssq[MTOK + brow + (ai) * HALF + i * 32 + wid * 4 + rg]; \
    _Pragma("unroll") for (int i = 0; i < 4; ++i) { const int row = i * 32 + wid * 4 + rg; \
      const float rl_ = __builtin_amdgcn_rsqf(sq_[i] * (1.f / LW) + EPS); float sq = 0.f; \
      _Pragma("unroll") for (int k = 0; k < 4; ++k) { const int c4 = l16 * 4 + 64 * k; \
        f32x4 a = *(const f32x4*)(C32 + row * 256 + (c4 ^ ((((wid & 3) << 2) + rg) << 2))); f32x4 yv = y[ai][i][k]; \
        yv[0] += rl_ * a[0]; yv[1] += rl_ * a[1]; yv[2] += rl_ * a[2]; yv[3] += rl_ * a[3]; y[ai][i][k] = yv; \
        sq += yv[0] * yv[0] + yv[1] * yv[1] + yv[2] * yv[2] + yv[3] * yv[3]; } \
      sq += __shfl_xor(sq, 1); sq += __shfl_xor(sq, 2); sq += __shfl_xor(sq, 4); sq += __shfl_xor(sq, 8); sq_[i] = sq; } \
      if (l16 == 0) { _Pragma("unroll") for (int i = 0; i < 4; ++i) atomicAdd(p.ssq + 2 * MTOK + brow + (ai) * HALF + i * 32 + wid * 4 + rg, sq_[i]); } } while (0)
    CSTAGE(0);
    XLOAD(0);
    __syncthreads();
    XLOAD(1);
    YCOMB(0);
    __syncthreads();
    CSTAGE(1);
    __syncthreads();
    YCOMB(1);
#undef XLOAD
#undef CSTAGE
#undef YCOMB
    unsigned* cnt = (unsigned*)p.ssq + 3 * MTOK + 16 + pm;
    asm volatile("s_waitcnt vmcnt(0)" ::: "memory");
    __syncthreads();
    if (tid == 0) {
      __threadfence();
      atomicAdd(cnt, 1u);
      while (__hip_atomic_load(cnt, __ATOMIC_ACQUIRE, __HIP_MEMORY_SCOPE_AGENT) < 8u) __builtin_amdgcn_s_sleep(2);
    }
    __syncthreads();
    float sy[2][4];
#pragma unroll
    for (int ai = 0; ai < 2; ++ai)
#pragma unroll
      for (int i = 0; i < 4; ++i)
        sy[ai][i] = __hip_atomic_load(p.ssq + 2 * MTOK + brow + ai * HALF + i * 32 + wid * 4 + rg, __ATOMIC_RELAXED, __HIP_MEMORY_SCOPE_AGENT);
    f32x4 g[4];
#pragma unroll
    for (int k = 0; k < 4; ++k) g[k] = *(const f32x4*)(p.fg + bcol + l16 * 4 + 64 * k);
#pragma unroll
    for (int ai = 0; ai < 2; ++ai)
#pragma unroll
      for (int i = 0; i < 4; ++i) {
        const unsigned xo = (unsigned)(brow + ai * HALF + i * 32 + wid * 4 + rg) * DM + bcol + l16 * 4;
        const float rs = __builtin_amdgcn_rsqf(sy[ai][i] * (1.f / DM) + EPS);
#pragma unroll
        for (int k = 0; k < 4; ++k) {
          f32x4 yv = y[ai][i][k];
          f32x4 o = {yv[0] * rs * g[k][0], yv[1] * rs * g[k][1], yv[2] * rs * g[k][2], yv[3] * rs * g[k][3]};
          __builtin_nontemporal_store(o, (f32x4*)(p.out + xo + 64 * k));
        }
      }
    __syncthreads();
  }
}

#define XB_TMO      128
#define XB_XCNT(j)  (256  + 64 * (j))
#define XB_XSUB(j)  (1280 + 64 * (j))
#define XB_XGEN(j)  (2304 + 64 * (j))
#define XB_TOP      3328
#define XB_TOPGEN   3392
#define XCD_BAR_WORDS 3456
#define XB_SPIN_CAP (1u << 18)
#define LAS __attribute__((address_space(3)))

__device__ __forceinline__ unsigned xb_ld(unsigned* p)              { return __hip_atomic_load(p, __ATOMIC_RELAXED, __HIP_MEMORY_SCOPE_AGENT); }
__device__ __forceinline__ unsigned xb_add(unsigned* p, unsigned v) { return __hip_atomic_fetch_add(p, v, __ATOMIC_RELAXED, __HIP_MEMORY_SCOPE_AGENT); }
__device__ __forceinline__ unsigned xb_xcc_id() { return (unsigned)__builtin_amdgcn_s_getreg((3 << 11) | 20) & 0xFu; }
#define XB_SPIN(cond, bar) do { unsigned _sp = 0; while (cond) { __builtin_amdgcn_s_sleep(1); \
    if ((++_sp & 255u) == 0u) { if (xb_ld(&(bar)[XB_TMO])) break; if (_sp > XB_SPIN_CAP) { atomicAdd(&(bar)[XB_TMO], 1u); break; } } } } while (0)

struct XcdBarrier {
    unsigned* bar; unsigned x;
    volatile LAS unsigned* st;
};

__device__ __forceinline__ XcdBarrier xcd_barrier_post(unsigned* bar, volatile LAS unsigned* st) {
    XcdBarrier b; b.bar = bar; b.x = xb_xcc_id(); b.st = st;
    if (threadIdx.x == 0) (void)xb_add(&bar[XB_XCNT(b.x)], 1u);
    return b;
}
__device__ __forceinline__ void xcd_barrier_complete(unsigned* bar, unsigned x, unsigned& nloc, unsigned& nx) {
    const unsigned G = gridDim.x * gridDim.y * gridDim.z;
    unsigned sum, cnt, mine, sp = 0u;
    for (;;) {
        sum = 0u; cnt = 0u; mine = 0u;
#pragma unroll
        for (unsigned j = 0; j < 16; ++j) { const unsigned c = xb_ld(&bar[XB_XCNT(j)]); sum += c; cnt += (c > 0u) ? 1u : 0u; mine = (j == x) ? c : mine; }
        if (sum == G) break;
        __builtin_amdgcn_s_sleep(1);
        if ((++sp & 255u) == 0u) { if (xb_ld(&bar[XB_TMO])) break; if (sp > XB_SPIN_CAP) { atomicAdd(&bar[XB_TMO], 1u); break; } }
    }
    nloc = mine > 0u ? mine : 1u; nx = cnt > 0u ? cnt : 1u;
}

__device__ __forceinline__ void xcd_barrier(const XcdBarrier& b) {
    asm volatile("s_waitcnt vmcnt(0)" ::: "memory");
    __syncthreads();
    if (threadIdx.x == 0) {
        unsigned* bar = b.bar;
        __builtin_amdgcn_s_waitcnt(0);
        unsigned nloc = b.st[0], nx = b.st[1];
        if (nloc == 0u) { xcd_barrier_complete(bar, b.x, nloc, nx); b.st[0] = nloc; b.st[1] = nx; }
        const unsigned old = xb_add(&bar[XB_XSUB(b.x)], 1u);
        const unsigned gen = old / nloc;
        if (old + 1u == (gen + 1u) * nloc) {
            __builtin_amdgcn_fence(__ATOMIC_RELEASE, "agent");
            asm volatile("s_waitcnt vmcnt(0)" ::: "memory");
            const unsigned og = xb_add(&bar[XB_TOP], 1u);
            const unsigned tg = og / nx;
            if (og + 1u == (tg + 1u) * nx) xb_add(&bar[XB_TOPGEN], 1u);
            else XB_SPIN(xb_ld(&bar[XB_TOPGEN]) == tg, bar);
            __builtin_amdgcn_fence(__ATOMIC_ACQUIRE, "agent");
            xb_add(&bar[XB_XGEN(b.x)], 1u);
            asm volatile("s_waitcnt vmcnt(0)" ::: "memory");
        } else {
            XB_SPIN(xb_ld(&bar[XB_XGEN(b.x)]) == gen, bar);
            __builtin_amdgcn_fence(__ATOMIC_ACQUIRE, "agent");
            asm volatile("s_waitcnt vmcnt(0)" ::: "memory");
        }
    }
    __syncthreads();
}


__device__ __forceinline__ void phase_c(const Params& p) {
  if (blockIdx.x < NB * NH) cumsum_item(p, blockIdx.x);
  lru_phase<1>(p);
}
__device__ __forceinline__ void phase_d(const Params& p) {
  lru_carry_block(p);
  lru_phase<2>(p);
  for (int it = blockIdx.x; it < NB * NH * 16; it += gridDim.x) {
    const int b = it >> 7, hr = (it >> 4) & 7, xq = it & 15;
    int h1 = 0, h2 = 0;
#pragma unroll
    for (int h = 0; h < NH; ++h) {
      int rank = 0;
      const float bh_ = p.b_f[h];
#pragma unroll
      for (int g = 0; g < NH; ++g) { const float bg = p.b_f[g]; rank += (bg < bh_ || (bg == bh_ && g < h)) ? 1 : 0; }
      if (rank == hr) h1 = h;
      if (rank == 7 - hr) h2 = h;
    }
    attn_item(p, b, h1, 31 - xq);
    __syncthreads();
    attn_item(p, b, h2, xq);
    __syncthreads();
  }
}

__global__ void __launch_bounds__(NTHR, 2) hymba_fwd(Params p) {
  cg::grid_group grid = cg::this_grid();
  __shared__ uint4 xb_words;
  if (threadIdx.x == 0) xb_words = make_uint4(0u, 0u, 0u, 0u);
  __syncthreads();
#define SEAM() do { XcdBarrier xb_; xb_.bar = p.bar; xb_.x = xb_xcc_id(); xb_.st = (volatile LAS unsigned*)&xb_words; xcd_barrier(xb_); } while (0)
  (void)xcd_barrier_post(p.bar, (volatile LAS unsigned*)&xb_words);
  phase_prep(p);
  if (p.bar == nullptr) grid.sync(); else SEAM();
  phase_inproj(p);
  SEAM();
  phase_c(p);
  SEAM();
  phase_d(p);
  SEAM();
  phase_outproj(p);
#undef SEAM
}

extern "C" void kernel_launch(void* const* d_in, const int* in_sizes, int n_in, void* d_out, int out_size, void* d_ws, size_t ws_size,
                              hipStream_t stream) {
  Params p{};
  p.x = (const float*)d_in[0]; p.norm_g = (const float*)d_in[1]; p.w_in = (const float*)d_in[2]; p.b_f = (const float*)d_in[3];
  p.conv_w = (const float*)d_in[4]; p.conv_b = (const float*)d_in[5]; p.w_rg = (const float*)d_in[6]; p.b_rg = (const float*)d_in[7];
  p.w_ig = (const float*)d_in[8]; p.b_ig = (const float*)d_in[9]; p.lam = (const float*)d_in[10]; p.ag = (const float*)d_in[11];
  p.lg = (const float*)d_in[12]; p.w_out = (const float*)d_in[13]; p.fg = (const float*)d_in[14];
  p.out = (float*)d_out;
  char* ws = (char*)d_ws; size_t off = 0;
  auto take = [&](size_t bytes) { char* r = ws + off; off += (bytes + 255) & ~(size_t)255; return r; };
  p.hb = (u16*)take((size_t)MTOK * DM * 2);
  p.WinT = (u16*)take((size_t)NP * KD * 2);
  p.WoutT = (u16*)take((size_t)DM * KD * 2);
  p.WgT = (u16*)take((size_t)16 * 128 * 128 * 2);
  p.qb = (u16*)take((size_t)MTOK * AW * 2);
  p.kb = (u16*)take((size_t)MTOK * AW * 2);
  p.vT = (u16*)take((size_t)MTOK * AW * 2);
  p.za = (u16*)take((size_t)MTOK * AW * 2);
  p.xl = (u16*)take((size_t)MTOK * LW * 2);
  p.zl = (u16*)take((size_t)MTOK * LW * 2);
  p.mixed = (u16*)take((size_t)MTOK * DM * 2);
  p.logf = (float*)take((size_t)NB * NH * SEQ * 4);
  p.c2 = (float*)take((size_t)NB * NH * SEQ * 4);
  p.ssq = (float*)take((size_t)(3 * MTOK + 16 + 64) * 4);
  p.lruA = (float*)take((size_t)NB * NCHUNK * LW * 4);
  p.lruH = (float*)take((size_t)NB * NCHUNK * LW * 4);
  p.bar = (unsigned*)take((size_t)4096 * 4);

  static int grid_blocks = 0;
  if (!grid_blocks) {
    hipFuncSetAttribute((const void*)hymba_fwd, hipFuncAttributeMaxDynamicSharedMemorySize, SHM_TOTAL);
    int dev = 0, cus = 0, per_cu = 0;
    hipGetDevice(&dev);
    hipDeviceGetAttribute(&cus, hipDeviceAttributeMultiprocessorCount, dev);
    hipOccupancyMaxActiveBlocksPerMultiprocessor(&per_cu, hymba_fwd, NTHR, SHM_TOTAL);
    if (per_cu < 1) per_cu = 1;
    grid_blocks = 256;
    (void)per_cu; (void)cus;
  }
  hipMemsetAsync(p.bar, 0, (size_t)4096 * 4, stream);
  void* args[] = {&p};
  hipError_t e = hipLaunchCooperativeKernel((const void*)hymba_fwd, dim3(grid_blocks), dim3(NTHR), args, SHM_TOTAL, stream);
  if (e != hipSuccess) fprintf(stderr, "cooperative launch failed: %s (grid %d)\n", hipGetErrorString(e), grid_blocks);
}
```

```cpp
#include <hip/hip_runtime.h>
#include <hip/hip_bf16.h>
#include <hip/hip_cooperative_groups.h>
#include <cstdio>
#include <cstdint>
namespace cg = cooperative_groups;

typedef unsigned short u16;
typedef short bf16x8 __attribute__((ext_vector_type(8)));
typedef float f32x4 __attribute__((ext_vector_type(4)));
typedef float f32x16 __attribute__((ext_vector_type(16)));
typedef unsigned u32x4 __attribute__((ext_vector_type(4)));
typedef unsigned u32x2 __attribute__((ext_vector_type(2)));
typedef __bf16 bf2_t __attribute__((ext_vector_type(2)));
typedef float f2_t __attribute__((ext_vector_type(2)));

#ifndef SINGLE_LAUNCH
#define SINGLE_LAUNCH 1
#endif

constexpr int NB = 2, SEQ = 8192, DM = 2048, MTOK = NB * SEQ, NH = 8, HD = 128, AW = 1024, LW = 1024;
constexpr int NIN = 6152, NP = 6144, KD = 2048;
constexpr int NTHR = 512;
constexpr float EPS = 1e-6f;
constexpr float LOG2E = 1.4426950408889634f;
constexpr float QSCALE = 0.08838834764831845f * 1.4426950408889634f;
constexpr int CHUNK = 64, NCHUNK = SEQ / CHUNK;

struct Params {
  const float *x, *norm_g, *w_in, *b_f, *conv_w, *conv_b, *w_rg, *b_rg, *w_ig, *b_ig, *lam, *ag, *lg, *w_out, *fg;
  float* out;
  u16 *hb, *WinT, *WoutT, *WgT, *qb, *kb, *vT, *za, *xl, *zl, *mixed;
  float *logf, *c2, *ssq, *lruA, *lruH;
  unsigned* bar;
};

extern __shared__ __attribute__((aligned(16))) char smem[];

__device__ __forceinline__ unsigned cvtpk(float lo, float hi) {
  f2_t v = {lo, hi}; bf2_t r = __builtin_convertvector(v, bf2_t); return __builtin_bit_cast(unsigned, r);
}
__device__ __forceinline__ float bflo(unsigned u) { return __uint_as_float(u << 16); }
__device__ __forceinline__ float bfhi(unsigned u) { return __uint_as_float(u & 0xffff0000u); }
__device__ __forceinline__ float wsum(float v) {
#pragma unroll
  for (int o = 32; o; o >>= 1) v += __shfl_xor(v, o);
  return v;
}
__device__ __forceinline__ float xh_max(float v) {
  auto rr = __builtin_amdgcn_permlane32_swap(__float_as_uint(v), __float_as_uint(v), false, false);
  return fmaxf(__uint_as_float(rr[0]), __uint_as_float(rr[1]));
}
__device__ __forceinline__ float xh_sum(float v) {
  auto rr = __builtin_amdgcn_permlane32_swap(__float_as_uint(v), __float_as_uint(v), false, false);
  return __uint_as_float(rr[0]) + __uint_as_float(rr[1]);
}
__device__ __forceinline__ float frcp_(float x) { return __builtin_amdgcn_rcpf(x); }
__device__ __forceinline__ float fexp_(float x) { return __builtin_amdgcn_exp2f(x * LOG2E); }
__device__ __forceinline__ float sigmoidf_(float x) { return frcp_(1.f + fexp_(-x)); }
__device__ __forceinline__ float siluf_(float x) { return x * frcp_(1.f + fexp_(-x)); }
__device__ __forceinline__ float log_sigmoidf_(float x) { return fminf(x, 0.f) - log1pf(__expf(-fabsf(x))); }

struct TrDesc { const float* src; u16* dst; const float* ksc; int ld_src, ld_dst; };
__device__ __forceinline__ TrDesc tr_desc(const Params& p, int t) {
  TrDesc d;
  if (t < 3072) {
    const int kt = t & 31, nt = t >> 5, n0 = nt * 64;
    const int sc0 = n0 + (n0 >= 3072 ? 8 : 0);
    d.src = p.w_in + (long)kt * 64 * NIN + sc0; d.ld_src = NIN; d.dst = p.WinT + (long)n0 * KD + kt * 64; d.ld_dst = KD; d.ksc = nullptr;
  } else if (t < 4096) {
    const int u = t - 3072, kt = u & 31, nt = u >> 5;
    d.ksc = (kt < 16) ? (p.ag + kt * 64) : (p.lg + (kt - 16) * 64);
    d.src = p.w_out + (long)kt * 64 * DM + nt * 64; d.ld_src = DM; d.dst = p.WoutT + (long)nt * 64 * KD + kt * 64; d.ld_dst = KD;
  } else {
    const int u = t - 4096, mat = u >> 2, sub = u & 3, kt = sub & 1, nt = sub >> 1;
    const float* sm = (mat < 8) ? (p.w_rg + mat * 16384) : (p.w_ig + (mat - 8) * 16384);
    d.src = sm + kt * 64 * 128 + nt * 64; d.ld_src = 128; d.dst = p.WgT + mat * 16384 + nt * 64 * 128 + kt * 64; d.ld_dst = 128; d.ksc = nullptr;
  }
  return d;
}

__device__ void phase_prep(const Params& p) {
  int tid = threadIdx.x; asm volatile("" : "+v"(tid));
  const int lane = tid & 63, wid = tid >> 6;
  for (int i = blockIdx.x * NTHR + tid; i < 3 * MTOK + 16 + 64; i += gridDim.x * NTHR) p.ssq[i] = 0.f;
  {
    constexpr int NT = 3072 + 1024 + 64;
    float* T = (float*)smem + wid * (64 * 65);
    const int r4 = lane >> 4, c4 = (lane & 15) * 4;
    const int n8 = lane >> 3, k8 = (lane & 7) * 8;
    for (int t = blockIdx.x * 8 + wid; t < NT; t += 8 * gridDim.x) {
      const TrDesc d = tr_desc(p, t);
      f32x4 v[16]; float sc[16];
#pragma unroll
      for (int i = 0; i < 16; ++i) {
        const int rr = i * 4 + r4;
        v[i] = __builtin_nontemporal_load((const f32x4*)(d.src + (long)rr * d.ld_src + c4));
        sc[i] = d.ksc ? d.ksc[rr] : 1.f;
      }
#pragma unroll
      for (int i = 0; i < 16; ++i) {
        const int rr = i * 4 + r4;
        T[rr * 65 + c4 + 0] = v[i][0] * sc[i]; T[rr * 65 + c4 + 1] = v[i][1] * sc[i];
        T[rr * 65 + c4 + 2] = v[i][2] * sc[i]; T[rr * 65 + c4 + 3] = v[i][3] * sc[i];
      }
#pragma unroll
      for (int j = 0; j < 8; ++j) {
        const int n = n8 + 8 * j;
        float tt[8];
#pragma unroll
        for (int i = 0; i < 8; ++i) tt[i] = T[(k8 + i) * 65 + n];
        u32x4 pk = {cvtpk(tt[0], tt[1]), cvtpk(tt[2], tt[3]), cvtpk(tt[4], tt[5]), cvtpk(tt[6], tt[7])};
        *(u32x4*)(d.dst + (long)n * d.ld_dst + k8) = pk;
      }
    }
  }
  __syncthreads();
  f32x4* WF = (f32x4*)smem;
  for (int idx = tid; idx < 4096; idx += NTHR) {
    const int ln = idx & 63, half = (idx >> 6) & 1, e = (idx >> 7) & 3, i = idx >> 9;
    const int k = (i * 64 + ln) * 4 + e;
    WF[idx] = *(const f32x4*)(p.w_in + (long)k * NIN + 3072 + half * 4);
  }
  __syncthreads();
  f32x4 xn[8];
  {
    const f32x4* xr = (const f32x4*)(p.x + (long)(blockIdx.x * 8 + wid) * DM);
#pragma unroll
    for (int i = 0; i < 8; ++i) xn[i] = __builtin_nontemporal_load(xr + i * 64 + lane);
  }
  for (int row = blockIdx.x * 8 + wid; row < MTOK; row += gridDim.x * 8) {
    f32x4 xv[8];
#pragma unroll
    for (int i = 0; i < 8; ++i) xv[i] = xn[i];
    if (row + (int)gridDim.x * 8 < MTOK) {
      const f32x4* xr = (const f32x4*)(p.x + (long)(row + gridDim.x * 8) * DM);
#pragma unroll
      for (int i = 0; i < 8; ++i) xn[i] = __builtin_nontemporal_load(xr + i * 64 + lane);
    }
    float ss = 0.f;
#pragma unroll
    for (int i = 0; i < 8; ++i) ss += xv[i][0] * xv[i][0] + xv[i][1] * xv[i][1] + xv[i][2] * xv[i][2] + xv[i][3] * xv[i][3];
    ss = wsum(ss);
    const float rs = rsqrtf(ss * (1.f / DM) + EPS);
    float f[8];
#pragma unroll
    for (int q = 0; q < 8; ++q) f[q] = 0.f;
#pragma unroll
    for (int i = 0; i < 8; ++i) {
      f32x4 g = ((const f32x4*)p.norm_g)[i * 64 + lane];
      float hv[4];
#pragma unroll
      for (int e = 0; e < 4; ++e) hv[e] = xv[i][e] * rs * g[e];
      u32x2 pk = {cvtpk(hv[0], hv[1]), cvtpk(hv[2], hv[3])};
      *(u32x2*)(p.hb + (long)row * DM + (i * 64 + lane) * 4) = pk;
#pragma unroll
      for (int e = 0; e < 4; ++e) {
        f32x4 wa = WF[((i * 4 + e) * 2 + 0) * 64 + lane], wb = WF[((i * 4 + e) * 2 + 1) * 64 + lane];
        f[0] += hv[e] * wa[0]; f[1] += hv[e] * wa[1]; f[2] += hv[e] * wa[2]; f[3] += hv[e] * wa[3];
        f[4] += hv[e] * wb[0]; f[5] += hv[e] * wb[1]; f[6] += hv[e] * wb[2]; f[7] += hv[e] * wb[3];
      }
      __builtin_amdgcn_sched_barrier(0);
    }
#pragma unroll
    for (int q = 0; q < 8; ++q) f[q] = wsum(f[q]);
    if (lane == 0) {
      const int b = row / SEQ, s = row % SEQ;
#pragma unroll
      for (int q = 0; q < 8; ++q) p.logf[(b * NH + q) * SEQ + s] = log_sigmoidf_(f[q] + p.b_f[q]);
    }
  }
  __syncthreads();
}

constexpr int BM = 256, BK = 64, HALF = 128, HT = HALF * BK;
constexpr int SHM_BYTES = 8 * HT * 2;
constexpr int SHM_TOTAL = 8 * 32 * 132 * 4;

__device__ __forceinline__ int lds_byte(int r, int c) {
  int st = (r >> 4) * 2 + (c >> 5), rr = r & 15, cc = c & 31, ob = rr * 64 + cc * 2;
  return st * 1024 + (ob ^ (((ob >> 9) & 1) << 5));
}
__device__ __forceinline__ void stage_rc(int b, int& R, int& C) {
  int st = b / 1024, sb = b % 1024, swz = sb ^ (((sb >> 9) & 1) << 5);
  R = (st >> 1) * 16 + swz / 64; C = (st & 1) * 32 + (swz % 64) / 2;
}

#define SA(b, h) ((u16*)smem + ((b) * 2 + (h)) * HT)
#define SB(b, h) ((u16*)smem + (4 + (b) * 2 + (h)) * HT)
#define STAGE(P, BASE, br, kt) do { const char* _u = (const char*)((BASE) + (long)(br) * KD + (long)(kt) * BK); \
    __builtin_amdgcn_global_load_lds((const unsigned*)(_u + soff0), (unsigned*)((char*)(P) + gtid * 16), 16, 0, 0); \
    __builtin_amdgcn_global_load_lds((const unsigned*)(_u + soff1), (unsigned*)((char*)(P) + gtid * 16 + 8192), 16, 0, 0); } while (0)
#define LDA(dst, b, h) for (int m = 0; m < 4; ++m) for (int k = 0; k < 2; ++k) \
    dst[m][k] = *reinterpret_cast<const bf16x8*>((char*)SA(b, h) + lds_byte(wr * 64 + m * 16 + fr, k * 32 + fq * 8))
#define LDB(dst, b, h) for (int n = 0; n < 2; ++n) for (int k = 0; k < 2; ++k) \
    dst[n][k] = *reinterpret_cast<const bf16x8*>((char*)SB(b, h) + lds_byte(wc * 32 + n * 16 + fr, k * 32 + fq * 8))
#define MMA(ai, bj, At, Bt_) do { __builtin_amdgcn_s_setprio(1); \
    for (int m = 0; m < 4; ++m) for (int n = 0; n < 2; ++n) for (int k = 0; k < 2; ++k) \
      acc[ai][bj][m][n] = __builtin_amdgcn_mfma_f32_16x16x32_bf16(Bt_[n][k], At[m][k], acc[ai][bj][m][n], 0, 0, 0); \
    __builtin_amdgcn_s_setprio(0); } while (0)
#define WAIT_V(n) asm volatile("s_waitcnt vmcnt(" #n ")" ::: "memory")
#define WAIT_L(n) asm volatile("s_waitcnt lgkmcnt(" #n ")" ::: "memory")
#define BAR __builtin_amdgcn_s_barrier()
#define SCHED __builtin_amdgcn_sched_barrier(0)

template <bool MID>
__device__ __forceinline__ void gemm_core(const u16* __restrict__ A, const u16* __restrict__ Bt, const int brow, const int bcol,
                                          f32x4 (&acc)[2][2][4][2], const float* __restrict__ ssq) {
  int gtid = threadIdx.x; asm volatile("" : "+v"(gtid));
  const int wid = gtid >> 6, lane = gtid & 63, wr = wid >> 2, wc = wid & 3, fr = lane & 15, fq = lane >> 4;
  unsigned soff0, soff1;
  { int r_, c_; stage_rc(gtid * 16, r_, c_); soff0 = (unsigned)(r_ * KD + c_) * 2u; stage_rc(gtid * 16 + 8192, r_, c_); soff1 = (unsigned)(r_ * KD + c_) * 2u; }
  bf16x8 At[4][2], B0[2][2], B1[2][2];
  constexpr int nt = KD / BK;
  STAGE(SB(0, 0), Bt, bcol, 0); STAGE(SA(0, 0), A, brow, 0);
  STAGE(SB(0, 1), Bt, bcol + HALF, 0); STAGE(SA(0, 1), A, brow + HALF, 0);
  if (wr == 1) BAR;
  WAIT_V(4); BAR;
  STAGE(SB(1, 0), Bt, bcol, 1); STAGE(SA(1, 0), A, brow, 1); STAGE(SB(1, 1), Bt, bcol + HALF, 1);
  WAIT_V(6); BAR;
  for (int t = 0; t < nt - 2; t += 2) {
    if (MID && t == 16) {
      const float* rt_ = (const float*)(smem + SHM_BYTES);
#pragma unroll
      for (int ai = 0; ai < 2; ++ai)
#pragma unroll
        for (int m = 0; m < 4; ++m) {
          const float ratio = rt_[ai * HALF + wr * 64 + m * 16 + fr];
#pragma unroll
          for (int bj = 0; bj < 2; ++bj)
#pragma unroll
            for (int n = 0; n < 2; ++n)
#pragma unroll
              for (int j = 0; j < 4; ++j) acc[ai][bj][m][n][j] *= ratio;
        }
    }
    LDB(B0, 0, 0); SCHED; LDA(At, 0, 0); STAGE(SA(1, 1), A, brow + HALF, t + 1);
    WAIT_L(8); BAR; WAIT_L(0); MMA(0, 0, At, B0); BAR; SCHED;
    LDB(B1, 0, 1); STAGE(SB(0, 0), Bt, bcol, t + 2);
    BAR; WAIT_L(0); MMA(0, 1, At, B1); BAR;
    LDA(At, 0, 1); STAGE(SA(0, 0), A, brow, t + 2);
    BAR; WAIT_L(0); MMA(1, 0, At, B0); BAR; SCHED;
    STAGE(SB(0, 1), Bt, bcol + HALF, t + 2);
    WAIT_V(6); BAR; MMA(1, 1, At, B1); BAR;
    LDB(B0, 1, 0); SCHED; LDA(At, 1, 0); STAGE(SA(0, 1), A, brow + HALF, t + 2);
    WAIT_L(8); BAR; WAIT_L(0); MMA(0, 0, At, B0); BAR; SCHED;
    LDB(B1, 1, 1); STAGE(SB(1, 0), Bt, bcol, t + 3);
    BAR; WAIT_L(0); MMA(0, 1, At, B1); BAR;
    LDA(At, 1, 1); STAGE(SA(1, 0), A, brow, t + 3);
    BAR; WAIT_L(0); MMA(1, 0, At, B0); BAR; SCHED;
    STAGE(SB(1, 1), Bt, bcol + HALF, t + 3);
    WAIT_V(6); BAR; MMA(1, 1, At, B1); BAR;
  }
  { LDB(B0, 0, 0); LDA(At, 0, 0); STAGE(SA(1, 1), A, brow + HALF, nt - 1);
    BAR; WAIT_L(0); MMA(0, 0, At, B0); BAR;
    LDB(B1, 0, 1); BAR; WAIT_L(0); MMA(0, 1, At, B1); BAR;
    LDA(At, 0, 1); WAIT_V(4); BAR; WAIT_L(0); MMA(1, 0, At, B0); MMA(1, 1, At, B1); BAR; }
  { LDB(B0, 1, 0); LDA(At, 1, 0); WAIT_V(2); BAR; WAIT_L(0); MMA(0, 0, At, B0); BAR;
    LDB(B1, 1, 1); WAIT_V(0); BAR; WAIT_L(0); MMA(0, 1, At, B1); BAR;
    LDA(At, 1, 1); BAR; WAIT_L(0); MMA(1, 0, At, B0); MMA(1, 1, At, B1); BAR; }
  if (wr == 0) BAR;
}

__device__ __forceinline__ void tile_map(int round, int nPatchN, int& pm, int& pn) {
  const int xcd = blockIdx.x & 7, local = blockIdx.x >> 3;
  const int patch = round * 8 + xcd;
  const int pmm = patch / nPatchN, pnn = patch % nPatchN;
  pm = pmm * 4 + (local & 3); pn = pnn * 8 + (local >> 2);
}

__device__ void phase_inproj(const Params& p) {
  for (int round = 0; round < 6; ++round) {
    int pm, pn; tile_map(round, 3, pm, pn);
    const int brow = pm * BM, bcol = pn * BM;
    f32x4 acc[2][2][4][2] = {};
    gemm_core<false>(p.hb, p.WinT, brow, bcol, acc, nullptr);
    __syncthreads();
    int tid = threadIdx.x; asm volatile("" : "+v"(tid));
    const int wid = tid >> 6, lane = tid & 63, wr = wid >> 2, wc = wid & 3, fr = lane & 15, fq = lane >> 4;
    const int region = pn >> 2;
    const int cofs = (pn & 3) * 256;
    const float osc = (region == 0) ? QSCALE : 1.f;
    u16* C16 = (u16*)smem;
    float kn2 = 0.f;
    if (region != 2) {
#pragma unroll
      for (int ai = 0; ai < 2; ++ai)
#pragma unroll
        for (int bj = 0; bj < 2; ++bj)
#pragma unroll
          for (int m = 0; m < 4; ++m)
#pragma unroll
            for (int n = 0; n < 2; ++n) {
              const int r = wr * 64 + m * 16 + fr, c = bj * 128 + wc * 32 + n * 16 + fq * 4;
              u32x2 pk = {cvtpk(acc[ai][bj][m][n][0] * osc, acc[ai][bj][m][n][1] * osc), cvtpk(acc[ai][bj][m][n][2] * osc, acc[ai][bj][m][n][3] * osc)};
              *(u32x2*)(C16 + ai * 33792 + r * 264 + c) = pk;
            }
      __syncthreads();
      u16* dst = (region == 0) ? p.qb : (region == 1) ? p.kb : (region == 3) ? p.za : (region == 4) ? p.xl : p.zl;
#pragma unroll
      for (int ai = 0; ai < 2; ++ai)
#pragma unroll
        for (int i = 0; i < 8; ++i) {
          const int id = tid + NTHR * i, r = id >> 5, c8 = (id & 31) * 8;
          u32x4 v = *(const u32x4*)(C16 + ai * 33792 + r * 264 + c8);
          *(u32x4*)(dst + (long)(brow + ai * HALF + r) * 1024 + cofs + c8) = v;
          if (region == 1) {
            float s2 = 0.f;
#pragma unroll
            for (int e = 0; e < 4; ++e) { const float a = bflo(v[e]), bq = bfhi(v[e]); s2 += a * a + bq * bq; }
            s2 += __shfl_xor(s2, 1); s2 += __shfl_xor(s2, 2); s2 += __shfl_xor(s2, 4); s2 += __shfl_xor(s2, 8);
            kn2 = fmaxf(kn2, s2);
          }
        }
      __syncthreads();
    } else {
#pragma unroll
      for (int ai = 0; ai < 2; ++ai) {
#pragma unroll
        for (int bj = 0; bj < 2; ++bj)
#pragma unroll
          for (int m = 0; m < 4; ++m)
#pragma unroll
            for (int n = 0; n < 2; ++n) {
              const int r = wr * 64 + m * 16 + fr, c = bj * 128 + wc * 32 + n * 16 + fq * 4;
#pragma unroll
              for (int j = 0; j < 4; ++j) C16[(c + j) * 136 + r] = (u16)cvtpk(acc[ai][bj][m][n][j], 0.f);
            }
        __syncthreads();
        const int b = brow / SEQ, s0 = brow % SEQ + ai * HALF;
#pragma unroll
        for (int i = 0; i < 8; ++i) {
          const int id = tid + NTHR * i, c = id >> 4, r8 = (id & 15) * 8;
          u32x4 v = *(const u32x4*)(C16 + c * 136 + r8);
          const int head = (pn & 3) * 2 + (c >> 7), d = c & 127;
          *(u32x4*)(p.vT + ((long)(b * NH + head) * HD + d) * SEQ + s0 + r8) = v;
        }
        __syncthreads();
      }
    }
    if (region == 1) {
      kn2 = fmaxf(kn2, __shfl_xor(kn2, 32));
      if ((lane & 47) == 0)
        atomicMax((unsigned*)p.ssq + 3 * MTOK + (brow / SEQ) * NH + (pn & 3) * 2 + ((lane >> 4) & 1), __float_as_uint(kn2));
    }
  }
}

__device__ void cumsum_item(const Params& p, int bh) {
  int tid = threadIdx.x; asm volatile("" : "+v"(tid));
  const int lane = tid & 63, wid = tid >> 6;
  float* wtot = (float*)smem;
  const float* src = p.logf + bh * SEQ + tid * 16;
  float v[16];
#pragma unroll
  for (int i = 0; i < 4; ++i) { f32x4 t = *(const f32x4*)(src + i * 4); v[i * 4] = t[0]; v[i * 4 + 1] = t[1]; v[i * 4 + 2] = t[2]; v[i * 4 + 3] = t[3]; }
#pragma unroll
  for (int i = 1; i < 16; ++i) v[i] += v[i - 1];
  float tot = v[15], inc = tot;
#pragma unroll
  for (int o = 1; o < 64; o <<= 1) { float u = __shfl_up(inc, o); if (lane >= o) inc += u; }
  if (lane == 63) wtot[wid] = inc;
  __syncthreads();
  float base = inc - tot;
  for (int w = 0; w < wid; ++w) base += wtot[w];
  float* dst = p.c2 + bh * SEQ + tid * 16;
#pragma unroll
  for (int i = 0; i < 4; ++i) {
    f32x4 t = {(v[i * 4] + base) * LOG2E, (v[i * 4 + 1] + base) * LOG2E, (v[i * 4 + 2] + base) * LOG2E, (v[i * 4 + 3] + base) * LOG2E};
    *(f32x4*)(dst + i * 4) = t;
  }
  __syncthreads();
}

template <int PASS>
__device__ void lru_phase(const Params& p) {
  int tid = threadIdx.x; asm volatile("" : "+v"(tid));
  const int lane = tid & 63, w = tid >> 6, fr = lane & 15, fq = lane >> 4;
  const int nb = blockIdx.x & 7, c0 = blockIdx.x >> 3;
  u16* Ub = (u16*)smem;
  float* U32 = (float*)(smem + 17408);
  float* Ab = (float*)(smem + 50176);
  float* Bb = (float*)(smem + 82944);
  float* sgA = (float*)(smem + 115712);
  float* sgH = sgA + 512;
  const float* CY = (const float*)(smem + 126976);
  bf16x8 bR[4], bI[4];
  {
    const u16* wr_ = p.WgT + (long)nb * 16384 + (w * 16 + fr) * 128 + fq * 8;
    const u16* wi_ = p.WgT + (long)(8 + nb) * 16384 + (w * 16 + fr) * 128 + fq * 8;
#pragma unroll
    for (int ks = 0; ks < 4; ++ks) { bR[ks] = *(const bf16x8*)(wr_ + ks * 32); bI[ks] = *(const bf16x8*)(wi_ + ks * 32); }
  }
  const int c8 = (tid & 15) * 8, tr = tid >> 4, gc = nb * 128 + c8;
  float cw[4][8], cb[8];
#pragma unroll
  for (int k = 0; k < 4; ++k) {
    f32x4 a = *(const f32x4*)(p.conv_w + k * LW + gc), bq = *(const f32x4*)(p.conv_w + k * LW + gc + 4);
    cw[k][0] = a[0]; cw[k][1] = a[1]; cw[k][2] = a[2]; cw[k][3] = a[3]; cw[k][4] = bq[0]; cw[k][5] = bq[1]; cw[k][6] = bq[2]; cw[k][7] = bq[3];
  }
  { f32x4 a = *(const f32x4*)(p.conv_b + gc), bq = *(const f32x4*)(p.conv_b + gc + 4);
    cb[0] = a[0]; cb[1] = a[1]; cb[2] = a[2]; cb[3] = a[3]; cb[4] = bq[0]; cb[5] = bq[1]; cb[6] = bq[2]; cb[7] = bq[3]; }
  const int chE = w * 16 + fr, gchE = nb * 128 + chE;
  const float br = p.b_rg[gchE], bi = p.b_ig[gchE];
  const float sp = log1pf(__expf(-p.lam[gchE]));
  const int ch = tid & 127, seg = tid >> 7;
  const int to = tid >> 3, c16 = (tid & 7) * 16;
  u32x4 xr[2][4];
#define LRU_PREFETCH(i_) do { const int b_ = (i_) >> 2, s0_ = (c0 + 32 * ((i_) & 3)) * CHUNK; const long tokb_ = (long)b_ * SEQ; \
    _Pragma("unroll") for (int tt = 0; tt < 2; ++tt) _Pragma("unroll") for (int k = 0; k < 4; ++k) { \
      const int sp_ = s0_ + tr + tt * 32 - 3 + k; u32x4 z_ = {0u, 0u, 0u, 0u}; \
      xr[tt][k] = (sp_ >= 0) ? __builtin_nontemporal_load((const u32x4*)(p.xl + (tokb_ + sp_) * LW + gc)) : z_; } \
    } while (0)
  LRU_PREFETCH(0);
#pragma unroll 1
  for (int it = 0; it < 8; ++it) {
    const int b = it >> 2, chunk = c0 + 32 * (it & 3), s0 = chunk * CHUNK;
    const long tokb = (long)b * SEQ;
    u32x4 z0, z1;
    if (PASS == 2) { const u16* zp_ = p.zl + (tokb + s0 + to) * LW + nb * 128 + c16; z0 = __builtin_nontemporal_load((const u32x4*)zp_); z1 = __builtin_nontemporal_load((const u32x4*)(zp_ + 8)); }
#pragma unroll
    for (int tt = 0; tt < 2; ++tt) {
      const int t = tr + tt * 32;
      f2_t u2[4];
#pragma unroll
      for (int e = 0; e < 4; ++e) { f2_t c_ = {cb[2 * e], cb[2 * e + 1]}; u2[e] = c_; }
#pragma unroll
      for (int k = 0; k < 4; ++k)
#pragma unroll
        for (int e = 0; e < 4; ++e) {
          f2_t w_ = {cw[k][2 * e], cw[k][2 * e + 1]}, x_ = {bflo(xr[tt][k][e]), bfhi(xr[tt][k][e])};
          u2[e] = w_ * x_ + u2[e];
        }
      f32x4 u0 = {u2[0][0], u2[0][1], u2[1][0], u2[1][1]}, u1 = {u2[2][0], u2[2][1], u2[3][0], u2[3][1]};
      *(f32x4*)(U32 + t * 128 + c8) = u0; *(f32x4*)(U32 + t * 128 + c8 + 4) = u1;
      u32x4 pk = {cvtpk(u2[0][0], u2[0][1]), cvtpk(u2[1][0], u2[1][1]), cvtpk(u2[2][0], u2[2][1]), cvtpk(u2[3][0], u2[3][1])};
      *(u32x4*)(Ub + t * 136 + c8) = pk;
    }
    if (it + 1 < 8) LRU_PREFETCH(it + 1);
    __syncthreads();
    f32x4 aR[4] = {}, aI[4] = {};
    {
      bf16x8 af[4];
#define ALD(i) af[(i) & 3] = *(const bf16x8*)(Ub + (((i) & 3) * 16 + fr) * 136 + ((i) >> 2) * 32 + fq * 8)
      ALD(0); ALD(1); ALD(2);
#pragma unroll
      for (int i = 0; i < 16; ++i) {
        if (i + 3 < 16) ALD(i + 3);
        aR[i & 3] = __builtin_amdgcn_mfma_f32_16x16x32_bf16(af[i & 3], bR[i >> 2], aR[i & 3], 0, 0, 0);
        aI[i & 3] = __builtin_amdgcn_mfma_f32_16x16x32_bf16(af[i & 3], bI[i >> 2], aI[i & 3], 0, 0, 0);
        __builtin_amdgcn_sched_barrier(0);
      }
#undef ALD
    }
    {
      const f2_t nl2 = {-LOG2E, -LOG2E}, one = {1.f, 1.f};
      const f2_t brs = {br * -LOG2E, br * -LOG2E}, bis = {bi * -LOG2E, bi * -LOG2E};
      const float c1s = -8.f * sp * LOG2E;
      const f2_t c1 = {c1s, c1s};
#pragma unroll
      for (int m = 0; m < 4; ++m)
#pragma unroll
        for (int j = 0; j < 4; j += 2) {
          const int t = m * 16 + fq * 4 + j;
          f2_t xr2 = {aR[m][j], aR[m][j + 1]}, xi2 = {aI[m][j], aI[m][j + 1]};
          f2_t tr2 = xr2 * nl2 + brs, ti2 = xi2 * nl2 + bis;
          f2_t e1 = {__builtin_amdgcn_exp2f(tr2[0]), __builtin_amdgcn_exp2f(tr2[1])};
          f2_t e2 = {__builtin_amdgcn_exp2f(ti2[0]), __builtin_amdgcn_exp2f(ti2[1])};
          f2_t d1 = e1 + one, d2 = e2 + one;
          f2_t r2 = {__builtin_amdgcn_rcpf(d1[0]), __builtin_amdgcn_rcpf(d1[1])};
          f2_t ig2 = {__builtin_amdgcn_rcpf(d2[0]), __builtin_amdgcn_rcpf(d2[1])};
          f2_t ta = r2 * c1;
          f2_t a2 = {__builtin_amdgcn_exp2f(ta[0]), __builtin_amdgcn_exp2f(ta[1])};
          f2_t om = one - a2 * a2;
          f2_t mu = {__builtin_amdgcn_sqrtf(om[0]), __builtin_amdgcn_sqrtf(om[1])};
          f2_t uu = {U32[t * 128 + chE], U32[(t + 1) * 128 + chE]};
          f2_t bt = mu * ig2 * uu;
          Ab[t * 128 + chE] = a2[0]; Ab[(t + 1) * 128 + chE] = a2[1];
          Bb[t * 128 + chE] = bt[0]; Bb[(t + 1) * 128 + chE] = bt[1];
        }
    }
    __syncthreads();
    {
      float A = 1.f, H = 0.f;
#pragma unroll
      for (int i = 0; i < 16; ++i) { const int t = seg * 16 + i; const float a = Ab[t * 128 + ch]; H = a * H + Bb[t * 128 + ch]; A *= a; }
      sgA[seg * 128 + ch] = A; sgH[seg * 128 + ch] = H;
    }
    __syncthreads();
    if (PASS == 1) {
      if (tid < 128) {
        float A = 1.f, H = 0.f;
#pragma unroll
        for (int s = 0; s < 4; ++s) { const float a = sgA[s * 128 + ch]; H = a * H + sgH[s * 128 + ch]; A *= a; }
        const unsigned oi = (unsigned)((b * NCHUNK + chunk) * LW + nb * 128 + ch);
        p.lruA[oi] = A;
        p.lruH[oi] = H;
      }
    } else {
      float H = CY[it * 128 + ch];
#pragma unroll
      for (int s = 0; s < 3; ++s) if (s < seg) H = sgA[s * 128 + ch] * H + sgH[s * 128 + ch];
#pragma unroll
      for (int i = 0; i < 16; ++i) { const int t = seg * 16 + i; H = Ab[t * 128 + ch] * H + Bb[t * 128 + ch]; Bb[t * 128 + ch] = H; }
      __syncthreads();
      const long tok = tokb + s0 + to;
      float h[16], ss = 0.f;
#pragma unroll
      for (int i = 0; i < 4; ++i) { f32x4 v = *(const f32x4*)(Bb + to * 128 + c16 + i * 4); h[i * 4] = v[0]; h[i * 4 + 1] = v[1]; h[i * 4 + 2] = v[2]; h[i * 4 + 3] = v[3]; }
#pragma unroll
      for (int i = 0; i < 16; ++i) ss += h[i] * h[i];
      ss += __shfl_xor(ss, 1); ss += __shfl_xor(ss, 2); ss += __shfl_xor(ss, 4);
      if ((tid & 7) == 0) atomicAdd(p.ssq + MTOK + tok, ss);
      unsigned o[8];
#pragma unroll
      for (int i = 0; i < 8; ++i) {
        const unsigned zw = (i < 4) ? z0[i & 3] : z1[i & 3];
        const f2_t z2 = {bflo(zw), bfhi(zw)}, h2 = {h[2 * i], h[2 * i + 1]}, nl2 = {-LOG2E, -LOG2E}, one = {1.f, 1.f};
        const f2_t t2 = z2 * nl2;
        const f2_t e2 = {__builtin_amdgcn_exp2f(t2[0]), __builtin_amdgcn_exp2f(t2[1])};
        const f2_t d2 = e2 + one;
        const f2_t iv = {__builtin_amdgcn_rcpf(d2[0]), __builtin_amdgcn_rcpf(d2[1])};
        const f2_t ov = h2 * z2 * iv;
        o[i] = cvtpk(ov[0], ov[1]);
      }
      u16* op = p.mixed + tok * DM + AW + nb * 128 + c16;
      u32x4 o0 = {o[0], o[1], o[2], o[3]}, o1 = {o[4], o[5], o[6], o[7]};
      *(u32x4*)op = o0; *(u32x4*)(op + 8) = o1;
    }
  }
  __syncthreads();
#undef LRU_PREFETCH
}

__device__ void lru_carry_block(const Params& p) {
  float* CY = (float*)(smem + 126976);
  float* TA = (float*)smem;
  float* TH = TA + 512;
  int tid = threadIdx.x; asm volatile("" : "+v"(tid));
  const int ch = tid & 127, sg = tid >> 7;
  const int nb = blockIdx.x & 7, c0 = blockIdx.x >> 3;
  const int lo = (sg == 0) ? 0 : c0 + 32 * (sg - 1), hi = c0 + 32 * sg;
  float av[NB][32], hv[NB][32];
#pragma unroll
  for (int b = 0; b < NB; ++b) {
    const float* pa = p.lruA + ((long)b * NCHUNK) * LW + nb * 128 + ch;
    const float* ph = p.lruH + ((long)b * NCHUNK) * LW + nb * 128 + ch;
#pragma unroll
    for (int u = 0; u < 32; ++u) {
      const int c = lo + u;
      const bool ok = c < hi;
      av[b][u] = ok ? pa[(long)c * LW] : 1.f;
      hv[b][u] = ok ? ph[(long)c * LW] : 0.f;
    }
  }
#pragma unroll
  for (int b = 0; b < NB; ++b) {
    float A = 1.f, H = 0.f;
#pragma unroll
    for (int u = 0; u < 32; ++u) { H = av[b][u] * H + hv[b][u]; A *= av[b][u]; }
    TA[sg * 128 + ch] = A; TH[sg * 128 + ch] = H;
    __syncthreads();
    if (tid < 128) {
      float Hc = 0.f;
#pragma unroll
      for (int i = 0; i < 4; ++i) { Hc = TA[i * 128 + ch] * Hc + TH[i * 128 + ch]; CY[(b * 4 + i) * 128 + ch] = Hc; }
    }
    __syncthreads();
  }
}

__device__ void attn_item(const Params& p, int b, int h, int qblk) {
  int tid = threadIdx.x; asm volatile("" : "+v"(tid));
  const int lane = tid & 63, w = tid >> 6, c = lane & 31, hi = lane >> 5;
  char* Kl = smem;
  char* Vl = smem + 34816;
  float* Cl = (float*)(smem + 69632);
  const int P0 = qblk * 256;
  const int qrow = P0 + w * 32 + c;
  const long tokb = (long)b * SEQ;
  const int bh = b * NH + h;
  bf16x8 qf[8];
  {
    const u16* qp = p.qb + (tokb + qrow) * AW + h * HD + hi * 8;
#pragma unroll
    for (int d0 = 0; d0 < 8; ++d0) qf[d0] = *(const bf16x8*)(qp + d0 * 16);
  }
  const float* c2 = p.c2 + (long)bh * SEQ;
  float* Wm = (float*)(smem + 69632 + 512);
  float ebase;
  {
    float q2 = 0.f;
#pragma unroll
    for (int d0 = 0; d0 < 8; ++d0) {
      u32x4 t = __builtin_bit_cast(u32x4, qf[d0]);
#pragma unroll
      for (int e = 0; e < 4; ++e) { const float a = bflo(t[e]), bq = bfhi(t[e]); q2 += a * a + bq * bq; }
    }
    q2 = xh_sum(q2);
    const float kmax = sqrtf(__uint_as_float(((const unsigned*)p.ssq)[3 * MTOK + bh])) * 1.001f;
    ebase = sqrtf(q2) * 1.001f * kmax;
  }
  constexpr float T2 = 40.f;
  f32x16 o[4];
#pragma unroll
  for (int dt = 0; dt < 4; ++dt)
#pragma unroll
    for (int r = 0; r < 16; ++r) o[dt][r] = 0.f;
  float mrun = -1e30f, lrun = 0.f, ewave = __builtin_inff();
  const int jhi = 4 * qblk + 3;
  const int kkey = tid >> 3, kc = (tid & 7) * 16;
  const int vd = tid >> 2, vk = (tid & 3) * 16;
  const u16* kg = p.kb + (tokb + kkey) * AW + h * HD + kc;
  const u16* vg = p.vT + ((long)bh * HD + vd) * SEQ + vk;
  u32x4 sk0A, sk1A, sv0A, sv1A, sk0B, sk1B, sv0B, sv1B; float scA = 0.f, scB = 0.f;
#define AT_GLOAD(S, j) do { const u16* kp_ = kg + (long)(j) * 64 * AW; sk0##S = *(const u32x4*)kp_; sk1##S = *(const u32x4*)(kp_ + 8); \
    const u16* vp_ = vg + (j) * 64; sv0##S = *(const u32x4*)vp_; sv1##S = *(const u32x4*)(vp_ + 8); if (tid < 64) sc##S = c2[(j) * 64 + tid]; } while (0)
#define AT_LSTORE(S, bf) do { char* kd_ = Kl + (bf) * 17408 + kkey * 272 + kc * 2; *(u32x4*)kd_ = sk0##S; *(u32x4*)(kd_ + 16) = sk1##S; \
    char* vd_ = Vl + (bf) * 17408 + vd * 136 + vk * 2; u32x2 a0_ = {sv0##S[0], sv0##S[1]}, a1_ = {sv0##S[2], sv0##S[3]}, a2_ = {sv1##S[0], sv1##S[1]}, a3_ = {sv1##S[2], sv1##S[3]}; \
    *(u32x2*)vd_ = a0_; *(u32x2*)(vd_ + 8) = a1_; *(u32x2*)(vd_ + 16) = a2_; *(u32x2*)(vd_ + 24) = a3_; if (tid < 64) Cl[(bf) * 64 + tid] = -sc##S; } while (0)
  AT_GLOAD(A, jhi);
  AT_GLOAD(B, jhi - 1);
  AT_LSTORE(A, 0);
  AT_GLOAD(A, jhi - 2);
  __syncthreads();
  auto tile_body = [&](const int buf, const int j, const int it) __attribute__((always_inline)) {
    const int k0 = 64 * j;
    if (k0 <= P0 + w * 32 + 31 && !(ewave + Cl[buf * 64 + 63] <= -T2)) {
      f32x16 p0, p1;
      {
        const float* ck = Cl + buf * 64 + 4 * hi;
#pragma unroll
        for (int g = 0; g < 4; ++g) {
          f32x4 v0 = *(const f32x4*)(ck + 8 * g), v1 = *(const f32x4*)(ck + 32 + 8 * g);
#pragma unroll
          for (int e = 0; e < 4; ++e) { p0[4 * g + e] = v0[e]; p1[4 * g + e] = v1[e]; }
        }
      }
      const char* kb_ = Kl + buf * 17408 + c * 272 + hi * 16;
      {
        bf16x8 kf[4][2];
#define KLD(d) do { kf[(d) & 3][0] = *(const bf16x8*)(kb_ + (d) * 32); kf[(d) & 3][1] = *(const bf16x8*)(kb_ + 32 * 272 + (d) * 32); } while (0)
        KLD(0); KLD(1); KLD(2);
#pragma unroll
        for (int d0 = 0; d0 < 8; ++d0) {
          if (d0 + 3 < 8) KLD(d0 + 3);
          p0 = __builtin_amdgcn_mfma_f32_32x32x16_bf16(kf[d0 & 3][0], qf[d0], p0, 0, 0, 0);
          p1 = __builtin_amdgcn_mfma_f32_32x32x16_bf16(kf[d0 & 3][1], qf[d0], p1, 0, 0, 0);
          __builtin_amdgcn_sched_barrier(0);
        }
#undef KLD
      }
      if (k0 + 63 > P0 + w * 32) {
        const float NEG = -__builtin_inff();
#pragma unroll
        for (int r = 0; r < 16; ++r) {
          const int key = k0 + (r & 3) + 8 * (r >> 2) + 4 * hi;
          if (key > qrow) p0[r] = NEG;
          if (key + 32 > qrow) p1[r] = NEG;
        }
      }
      float mx;
      {
        f32x16 mv = __builtin_elementwise_max(p0, p1);
        float m8[8];
#pragma unroll
        for (int r = 0; r < 8; ++r) m8[r] = fmaxf(mv[r], mv[r + 8]);
        mx = fmaxf(fmaxf(fmaxf(m8[0], m8[1]), fmaxf(m8[2], m8[3])), fmaxf(fmaxf(m8[4], m8[5]), fmaxf(m8[6], m8[7])));
      }
      mx = xh_max(mx);
      const float mn = fmaxf(mrun, mx);
      const float alpha = __builtin_amdgcn_exp2f(mrun - mn);
      mrun = mn;
      const bool moved = !__all(alpha == 1.f);
      if (moved) {
        float e = ebase - mn;
        e = fmaxf(e, __shfl_xor(e, 16)); e = fmaxf(e, __shfl_xor(e, 8)); e = fmaxf(e, __shfl_xor(e, 4));
        e = fmaxf(e, __shfl_xor(e, 2)); e = fmaxf(e, __shfl_xor(e, 1));
        ewave = e;
      }
      float ps;
      {
        p0 = p0 - mn; p1 = p1 - mn;
#pragma unroll
        for (int r = 0; r < 16; ++r) { p0[r] = __builtin_amdgcn_exp2f(p0[r]); p1[r] = __builtin_amdgcn_exp2f(p1[r]); }
        f32x16 sv = p0 + p1;
        f2_t s2 = {0.f, 0.f};
#pragma unroll
        for (int r = 0; r < 16; r += 2) { f2_t t_ = {sv[r], sv[r + 1]}; s2 += t_; }
        ps = s2[0] + s2[1];
      }
      ps = xh_sum(ps);
      lrun = lrun * alpha + ps;
      if (moved) {
#pragma unroll
        for (int dt = 0; dt < 4; ++dt)
#pragma unroll
          for (int r = 0; r < 16; ++r) o[dt][r] *= alpha;
      }
      bf16x8 pb[4];
      { u32x4 t0 = {cvtpk(p0[0], p0[1]), cvtpk(p0[2], p0[3]), cvtpk(p0[4], p0[5]), cvtpk(p0[6], p0[7])};
        u32x4 t1 = {cvtpk(p0[8], p0[9]), cvtpk(p0[10], p0[11]), cvtpk(p0[12], p0[13]), cvtpk(p0[14], p0[15])};
        u32x4 t2 = {cvtpk(p1[0], p1[1]), cvtpk(p1[2], p1[3]), cvtpk(p1[4], p1[5]), cvtpk(p1[6], p1[7])};
        u32x4 t3 = {cvtpk(p1[8], p1[9]), cvtpk(p1[10], p1[11]), cvtpk(p1[12], p1[13]), cvtpk(p1[14], p1[15])};
        pb[0] = __builtin_bit_cast(bf16x8, t0); pb[1] = __builtin_bit_cast(bf16x8, t1);
        pb[2] = __builtin_bit_cast(bf16x8, t2); pb[3] = __builtin_bit_cast(bf16x8, t3); }
      const char* vb_ = Vl + buf * 17408 + c * 136 + hi * 8;
      {
        u32x4 vv[4];
#define VLD(i) do { const char* a_ = vb_ + ((i) & 3) * 4352 + ((i) >> 2) * 32; u32x2 lo_ = *(const u32x2*)a_, hh_ = *(const u32x2*)(a_ + 16); \
          u32x4 t_ = {lo_[0], lo_[1], hh_[0], hh_[1]}; vv[(i) & 3] = t_; } while (0)
        VLD(0); VLD(1); VLD(2);
#pragma unroll
        for (int i = 0; i < 16; ++i) {
          if (i + 3 < 16) VLD(i + 3);
          o[i & 3] = __builtin_amdgcn_mfma_f32_32x32x16_bf16(__builtin_bit_cast(bf16x8, vv[i & 3]), pb[i >> 2], o[i & 3], 0, 0, 0);
          __builtin_amdgcn_sched_barrier(0);
        }
#undef VLD
      }
    }
    if (lane == 0 && k0 <= P0 + w * 32 + 31) Wm[(it & 1) * 8 + w] = ewave;
  };
#define AT_EXIT(buf_, it_) ((it_) >= 4 && ({ const float* wm = Wm + (((it_) - 1) & 1) * 8; \
      fmaxf(fmaxf(fmaxf(wm[0], wm[1]), fmaxf(wm[2], wm[3])), fmaxf(fmaxf(wm[4], wm[5]), fmaxf(wm[6], wm[7]))); }) + Cl[(buf_) * 64 + 63] <= -T2)
  int it = 0, j = jhi;
  for (;;) {
    if (AT_EXIT(0, it)) break;
    if (j > 0) AT_LSTORE(B, 1);
    if (j > 2) AT_GLOAD(B, j - 3);
    tile_body(0, j, it);
    __syncthreads();
    --j; ++it;
    if (j < 0) break;
    if (AT_EXIT(1, it)) break;
    if (j > 0) AT_LSTORE(A, 0);
    if (j > 2) AT_GLOAD(A, j - 3);
    tile_body(1, j, it);
    __syncthreads();
    --j; ++it;
    if (j < 0) break;
  }
#undef AT_EXIT
#undef AT_GLOAD
#undef AT_LSTORE
  u32x4 zz8[8];
#pragma unroll
  for (int i = 0; i < 8; ++i) {
    const int id = lane + 64 * i, row = id >> 4, d8 = (id & 15) * 8;
    zz8[i] = __builtin_nontemporal_load((const u32x4*)(p.za + (tokb + P0 + w * 32 + row) * AW + h * HD + d8));
  }
  __builtin_amdgcn_sched_barrier(0);
  const float inv = 1.f / lrun;
  float ss = 0.f;
#pragma unroll
  for (int dt = 0; dt < 4; ++dt)
#pragma unroll
    for (int r = 0; r < 16; ++r) { o[dt][r] *= inv; ss += o[dt][r] * o[dt][r]; }
  ss = xh_sum(ss);
  __syncthreads();
  float* Ot = (float*)smem + w * (32 * 132);
#pragma unroll
  for (int dt = 0; dt < 4; ++dt)
#pragma unroll
    for (int g = 0; g < 4; ++g) {
      f32x4 v = {o[dt][4 * g], o[dt][4 * g + 1], o[dt][4 * g + 2], o[dt][4 * g + 3]};
      *(f32x4*)(Ot + c * 132 + dt * 32 + 8 * g + 4 * hi) = v;
    }
#pragma unroll
  for (int i = 0; i < 8; ++i) {
    const int id = lane + 64 * i, row = id >> 4, d8 = (id & 15) * 8;
    const long tr = tokb + P0 + w * 32 + row;
    const u32x4 zz = zz8[i];
    f32x4 a0 = *(const f32x4*)(Ot + row * 132 + d8), a1 = *(const f32x4*)(Ot + row * 132 + d8 + 4);
    u32x4 ov = {cvtpk(a0[0] * siluf_(bflo(zz[0])), a0[1] * siluf_(bfhi(zz[0]))), cvtpk(a0[2] * siluf_(bflo(zz[1])), a0[3] * siluf_(bfhi(zz[1]))),
                cvtpk(a1[0] * siluf_(bflo(zz[2])), a1[1] * siluf_(bfhi(zz[2]))), cvtpk(a1[2] * siluf_(bflo(zz[3])), a1[3] * siluf_(bfhi(zz[3])))};
    *(u32x4*)(p.mixed + tr * DM + h * HD + d8) = ov;
  }
  if (hi == 0) atomicAdd(p.ssq + tokb + qrow, ss);
}

__device__ void phase_outproj(const Params& p) {
  for (int round = 0; round < 2; ++round) {
    int pm, pn; tile_map(round, 1, pm, pn);
    const int brow = pm * BM, bcol = pn * BM;
    f32x4 acc[2][2][4][2] = {};
    {
      const int t_ = threadIdx.x;
      if (t_ < BM) {
        const float ra = __builtin_amdgcn_rsqf(p.ssq[brow + t_] * (1.f / AW) + EPS), rl = __builtin_amdgcn_rsqf(p.ssq[MTOK + brow + t_] * (1.f / LW) + EPS);
        ((float*)(smem + SHM_BYTES))[t_] = ra * __builtin_amdgcn_rcpf(rl);
      }
    }
    gemm_core<true>(p.mixed, p.WoutT, brow, bcol, acc, p.ssq);
    __syncthreads();
    int tid = threadIdx.x; asm volatile("" : "+v"(tid));
    const int wid = tid >> 6, lane = tid & 63, wr = wid >> 2, wc = wid & 3, fr = lane & 15, fq = lane >> 4;
    const int rg = lane >> 4, l16 = lane & 15;
    float* C32 = (float*)smem;
    f32x4 y[2][4][4];
#define XLOAD(ai) do { _Pragma("unroll") for (int i = 0; i < 4; ++i) { const unsigned grow = brow + (ai) * HALF + i * 32 + wid * 4 + rg; \
      const unsigned xo = grow * DM + bcol + l16 * 4; \
      _Pragma("unroll") for (int k = 0; k < 4; ++k) y[ai][i][k] = __builtin_nontemporal_load((const f32x4*)(p.x + xo + 64 * k)); } } while (0)
#define CSTAGE(ai) do { _Pragma("unroll") for (int bj = 0; bj < 2; ++bj) _Pragma("unroll") for (int m = 0; m < 4; ++m) \
      _Pragma("unroll") for (int n = 0; n < 2; ++n) { \
        const int r = wr * 64 + m * 16 + fr, c = bj * 128 + wc * 32 + n * 16 + fq * 4; \
        *(f32x4*)(C32 + r * 256 + (c ^ (fr << 2))) = acc[ai][bj][m][n]; } } while (0)
#define YCOMB(ai) do { float sq_[4]; _Pragma("unroll") for (int i = 0; i < 4; ++i) sq_[i] = p.ssq[MTOK + brow + (ai) * HALF + i * 32 + wid * 4 + rg]; \
    _Pragma("unroll") for (int i = 0; i < 4; ++i) { const int row = i * 32 + wid * 4 + rg; \
      const float rl_ = __builtin_amdgcn_rsqf(sq_[i] * (1.f / LW) + EPS); float sq = 0.f; \
      _Pragma("unroll") for (int k = 0; k < 4; ++k) { const int c4 = l16 * 4 + 64 * k; \
        f32x4 a = *(const f32x4*)(C32 + row * 256 + (c4 ^ ((((wid & 3) << 2) + rg) << 2))); f32x4 yv = y[ai][i][k]; \
        yv[0] += rl_ * a[0]; yv[1] += rl_ * a[1]; yv[2] += rl_ * a[2]; yv[3] += rl_ * a[3]; y[ai][i][k] = yv; \
        sq += yv[0] * yv[0] + yv[1] * yv[1] + yv[2] * yv[2] + yv[3] * yv[3]; } \
      sq += __shfl_xor(sq, 1); sq += __shfl_xor(sq, 2); sq += __shfl_xor(sq, 4); sq += __shfl_xor(sq, 8); sq_[i] = sq; } \
      if (l16 == 0) { _Pragma("unroll") for (int i = 0; i < 4; ++i) atomicAdd(p.ssq + 2 * MTOK + brow + (ai) * HALF + i * 32 + wid * 4 + rg, sq_[i]); } } while (0)
    CSTAGE(0);
    XLOAD(0);
    __syncthreads();
    XLOAD(1);
    YCOMB(0);
    __syncthreads();
    CSTAGE(1);
    __syncthreads();
    YCOMB(1);
#undef XLOAD
#undef CSTAGE
#undef YCOMB
    unsigned* cnt = (unsigned*)p.ssq + 3 * MTOK + 16 + pm;
    asm volatile("s_waitcnt vmcnt(0)" ::: "memory");
    __syncthreads();
    if (tid == 0) {
      __threadfence();
      atomicAdd(cnt, 1u);
      while (__hip_atomic_load(cnt, __ATOMIC_ACQUIRE, __HIP_MEMORY_SCOPE_AGENT) < 8u) __builtin_amdgcn_s_sleep(2);
    }
    __syncthreads();
    float sy[2][4];
#pragma unroll
    for (int ai = 0; ai < 2; ++ai)
#pragma unroll
      for (int i = 0; i < 4; ++i)
        sy[ai][i] = __hip_atomic_load(p.ssq + 2 * MTOK + brow + ai * HALF + i * 32 + wid * 4 + rg, __ATOMIC_RELAXED, __HIP_MEMORY_SCOPE_AGENT);
    f32x4 g[4];
#pragma unroll
    for (int k = 0; k < 4; ++k) g[k] = *(const f32x4*)(p.fg + bcol + l16 * 4 + 64 * k);
#pragma unroll
    for (int ai = 0; ai < 2; ++ai)
#pragma unroll
      for (int i = 0; i < 4; ++i) {
        const unsigned xo = (unsigned)(brow + ai * HALF + i * 32 + wid * 4 + rg) * DM + bcol + l16 * 4;
        const float rs = __builtin_amdgcn_rsqf(sy[ai][i] * (1.f / DM) + EPS);
#pragma unroll
        for (int k = 0; k < 4; ++k) {
          f32x4 yv = y[ai][i][k];
          f32x4 o = {yv[0] * rs * g[k][0], yv[1] * rs * g[k][1], yv[2] * rs * g[k][2], yv[3] * rs * g[k][3]};
          __builtin_nontemporal_store(o, (f32x4*)(p.out + xo + 64 * k));
        }
      }
    __syncthreads();
  }
}

#define XB_TMO      128
#define XB_XCNT(j)  (256  + 64 * (j))
#define XB_XSUB(j)  (1280 + 64 * (j))
#define XB_XGEN(j)  (2304 + 64 * (j))
#define XB_TOP      3328
#define XB_TOPGEN   3392
#define XCD_BAR_WORDS 3456
#define XB_SPIN_CAP (1u << 18)
#define LAS __attribute__((address_space(3)))

__device__ __forceinline__ unsigned xb_ld(unsigned* p)              { return __hip_atomic_load(p, __ATOMIC_RELAXED, __HIP_MEMORY_SCOPE_AGENT); }
__device__ __forceinline__ unsigned xb_add(unsigned* p, unsigned v) { return __hip_atomic_fetch_add(p, v, __ATOMIC_RELAXED, __HIP_MEMORY_SCOPE_AGENT); }
__device__ __forceinline__ unsigned xb_xcc_id() { return (unsigned)__builtin_amdgcn_s_getreg((3 << 11) | 20) & 0xFu; }
#define XB_SPIN(cond, bar) do { unsigned _sp = 0; while (cond) { __builtin_amdgcn_s_sleep(1); \
    if ((++_sp & 255u) == 0u) { if (xb_ld(&(bar)[XB_TMO])) break; if (_sp > XB_SPIN_CAP) { atomicAdd(&(bar)[XB_TMO], 1u); break; } } } } while (0)

struct XcdBarrier {
    unsigned* bar; unsigned x;
    volatile LAS unsigned* st;
};

__device__ __forceinline__ XcdBarrier xcd_barrier_post(unsigned* bar, volatile LAS unsigned* st) {
    XcdBarrier b; b.bar = bar; b.x = xb_xcc_id(); b.st = st;
    if (threadIdx.x == 0) (void)xb_add(&bar[XB_XCNT(b.x)], 1u);
    return b;
}
__device__ __forceinline__ void xcd_barrier_complete(unsigned* bar, unsigned x, unsigned& nloc, unsigned& nx) {
    const unsigned G = gridDim.x * gridDim.y * gridDim.z;
    unsigned sum, cnt, mine, sp = 0u;
    for (;;) {
        sum = 0u; cnt = 0u; mine = 0u;
#pragma unroll
        for (unsigned j = 0; j < 16; ++j) { const unsigned c = xb_ld(&bar[XB_XCNT(j)]); sum += c; cnt += (c > 0u) ? 1u : 0u; mine = (j == x) ? c : mine; }
        if (sum == G) break;
        __builtin_amdgcn_s_sleep(1);
        if ((++sp & 255u) == 0u) { if (xb_ld(&bar[XB_TMO])) break; if (sp > XB_SPIN_CAP) { atomicAdd(&bar[XB_TMO], 1u); break; } }
    }
    nloc = mine > 0u ? mine : 1u; nx = cnt > 0u ? cnt : 1u;
}

__device__ __forceinline__ void xcd_barrier(const XcdBarrier& b) {
    asm volatile("s_waitcnt vmcnt(0)" ::: "memory");
    __syncthreads();
    if (threadIdx.x == 0) {
        unsigned* bar = b.bar;
        __builtin_amdgcn_s_waitcnt(0);
        unsigned nloc = b.st[0], nx = b.st[1];
        if (nloc == 0u) { xcd_barrier_complete(bar, b.x, nloc, nx); b.st[0] = nloc; b.st[1] = nx; }
        const unsigned old = xb_add(&bar[XB_XSUB(b.x)], 1u);
        const unsigned gen = old / nloc;
        if (old + 1u == (gen + 1u) * nloc) {
            __builtin_amdgcn_fence(__ATOMIC_RELEASE, "agent");
            asm volatile("s_waitcnt vmcnt(0)" ::: "memory");
            const unsigned og = xb_add(&bar[XB_TOP], 1u);
            const unsigned tg = og / nx;
            if (og + 1u == (tg + 1u) * nx) xb_add(&bar[XB_TOPGEN], 1u);
            else XB_SPIN(xb_ld(&bar[XB_TOPGEN]) == tg, bar);
            __builtin_amdgcn_fence(__ATOMIC_ACQUIRE, "agent");
            xb_add(&bar[XB_XGEN(b.x)], 1u);
            asm volatile("s_waitcnt vmcnt(0)" ::: "memory");
        } else {
            XB_SPIN(xb_ld(&bar[XB_XGEN(b.x)]) == gen, bar);
            __builtin_amdgcn_fence(__ATOMIC_ACQUIRE, "agent");
            asm volatile("s_waitcnt vmcnt(0)" ::: "memory");
        }
    }
    __syncthreads();
}


__device__ __forceinline__ void phase_c(const Params& p) {
  if (blockIdx.x < NB * NH) cumsum_item(p, blockIdx.x);
  lru_phase<1>(p);
}
__device__ __forceinline__ void phase_d(const Params& p) {
  lru_carry_block(p);
  lru_phase<2>(p);
  for (int it = blockIdx.x; it < NB * NH * 16; it += gridDim.x) {
    const int b = it >> 7, hr = (it >> 4) & 7, xq = it & 15;
    int h1 = 0, h2 = 0;
#pragma unroll
    for (int h = 0; h < NH; ++h) {
      int rank = 0;
      const float bh_ = p.b_f[h];
#pragma unroll
      for (int g = 0; g < NH; ++g) { const float bg = p.b_f[g]; rank += (bg < bh_ || (bg == bh_ && g < h)) ? 1 : 0; }
      if (rank == hr) h1 = h;
      if (rank == 7 - hr) h2 = h;
    }
    attn_item(p, b, h1, 31 - xq);
    __syncthreads();
    attn_item(p, b, h2, xq);
    __syncthreads();
  }
}

__global__ void __launch_bounds__(NTHR, 2) hymba_fwd(Params p) {
  cg::grid_group grid = cg::this_grid();
  __shared__ uint4 xb_words;
  if (threadIdx.x == 0) xb_words = make_uint4(0u, 0u, 0u, 0u);
  __syncthreads();
#define SEAM() do { XcdBarrier xb_; xb_.bar = p.bar; xb_.x = xb_xcc_id(); xb_.st = (volatile LAS unsigned*)&xb_words; xcd_barrier(xb_); } while (0)
  (void)xcd_barrier_post(p.bar, (volatile LAS unsigned*)&xb_words);
  phase_prep(p);
  if (p.bar == nullptr) grid.sync(); else SEAM();
  phase_inproj(p);
  SEAM();
  phase_c(p);
  SEAM();
  phase_d(p);
  SEAM();
  phase_outproj(p);
#undef SEAM
}

extern "C" void kernel_launch(void* const* d_in, const int* in_sizes, int n_in, void* d_out, int out_size, void* d_ws, size_t ws_size,
                              hipStream_t stream) {
  Params p{};
  p.x = (const float*)d_in[0]; p.norm_g = (const float*)d_in[1]; p.w_in = (const float*)d_in[2]; p.b_f = (const float*)d_in[3];
  p.conv_w = (const float*)d_in[4]; p.conv_b = (const float*)d_in[5]; p.w_rg = (const float*)d_in[6]; p.b_rg = (const float*)d_in[7];
  p.w_ig = (const float*)d_in[8]; p.b_ig = (const float*)d_in[9]; p.lam = (const float*)d_in[10]; p.ag = (const float*)d_in[11];
  p.lg = (const float*)d_in[12]; p.w_out = (const float*)d_in[13]; p.fg = (const float*)d_in[14];
  p.out = (float*)d_out;
  char* ws = (char*)d_ws; size_t off = 0;
  auto take = [&](size_t bytes) { char* r = ws + off; off += (bytes + 255) & ~(size_t)255; return r; };
  p.hb = (u16*)take((size_t)MTOK * DM * 2);
  p.WinT = (u16*)take((size_t)NP * KD * 2);
  p.WoutT = (u16*)take((size_t)DM * KD * 2);
  p.WgT = (u16*)take((size_t)16 * 128 * 128 * 2);
  p.qb = (u16*)take((size_t)MTOK * AW * 2);
  p.kb = (u16*)take((size_t)MTOK * AW * 2);
  p.vT = (u16*)take((size_t)MTOK * AW * 2);
  p.za = (u16*)take((size_t)MTOK * AW * 2);
  p.xl = (u16*)take((size_t)MTOK * LW * 2);
  p.zl = (u16*)take((size_t)MTOK * LW * 2);
  p.mixed = (u16*)take((size_t)MTOK * DM * 2);
  p.logf = (float*)take((size_t)NB * NH * SEQ * 4);
  p.c2 = (float*)take((size_t)NB * NH * SEQ * 4);
  p.ssq = (float*)take((size_t)(3 * MTOK + 16 + 64) * 4);
  p.lruA = (float*)take((size_t)NB * NCHUNK * LW * 4);
  p.lruH = (float*)take((size_t)NB * NCHUNK * LW * 4);
  p.bar = (unsigned*)take((size_t)4096 * 4);

  static int grid_blocks = 0;
  if (!grid_blocks) {
    hipFuncSetAttribute((const void*)hymba_fwd, hipFuncAttributeMaxDynamicSharedMemorySize, SHM_TOTAL);
    int dev = 0, cus = 0, per_cu = 0;
    hipGetDevice(&dev);
    hipDeviceGetAttribute(&cus, hipDeviceAttributeMultiprocessorCount, dev);
    hipOccupancyMaxActiveBlocksPerMultiprocessor(&per_cu, hymba_fwd, NTHR, SHM_TOTAL);
    if (per_cu < 1) per_cu = 1;
    grid_blocks = 256;
    (void)per_cu; (void)cus;
  }
  hipMemsetAsync(p.bar, 0, (size_t)4096 * 4, stream);
  void* args[] = {&p};
  hipError_t e = hipLaunchCooperativeKernel((const void*)hymba_fwd, dim3(grid_blocks), dim3(NTHR), args, SHM_TOTAL, stream);
  if (e != hipSuccess) fprintf(stderr, "cooperative launch failed: %s (grid %d)\n", hipGetErrorString(e), grid_blocks);
}
```

```cpp
#include <hip/hip_runtime.h>
#include <hip/hip_bf16.h>
#include <hip/hip_cooperative_groups.h>
#include <cstdio>
#include <cstdint>
namespace cg = cooperative_groups;

typedef unsigned short u16;
typedef short bf16x8 __attribute__((ext_vector_type(8)));
typedef float f32x4 __attribute__((ext_vector_type(4)));
typedef float f32x16 __attribute__((ext_vector_type(16)));
typedef unsigned u32x4 __attribute__((ext_vector_type(4)));
typedef unsigned u32x2 __attribute__((ext_vector_type(2)));
typedef __bf16 bf2_t __attribute__((ext_vector_type(2)));
typedef float f2_t __attribute__((ext_vector_type(2)));

#ifndef SINGLE_LAUNCH
#define SINGLE_LAUNCH 1
#endif

constexpr int NB = 2, SEQ = 8192, DM = 2048, MTOK = NB * SEQ, NH = 8, HD = 128, AW = 1024, LW = 1024;
constexpr int NIN = 6152, NP = 6144, KD = 2048;
constexpr int NTHR = 512;
constexpr float EPS = 1e-6f;
constexpr float LOG2E = 1.4426950408889634f;
constexpr float QSCALE = 0.08838834764831845f * 1.4426950408889634f;
constexpr int CHUNK = 64, NCHUNK = SEQ / CHUNK;

struct Params {
  const float *x, *norm_g, *w_in, *b_f, *conv_w, *conv_b, *w_rg, *b_rg, *w_ig, *b_ig, *lam, *ag, *lg, *w_out, *fg;
  float* out;
  u16 *hb, *WinT, *WoutT, *WgT, *qb, *kb, *vT, *za, *xl, *zl, *mixed;
  float *logf, *c2, *ssq, *lruA, *lruH;
  unsigned* bar;
};

extern __shared__ __attribute__((aligned(16))) char smem[];

__device__ __forceinline__ unsigned cvtpk(float lo, float hi) {
  f2_t v = {lo, hi}; bf2_t r = __builtin_convertvector(v, bf2_t); return __builtin_bit_cast(unsigned, r);
}
__device__ __forceinline__ float bflo(unsigned u) { return __uint_as_float(u << 16); }
__device__ __forceinline__ float bfhi(unsigned u) { return __uint_as_float(u & 0xffff0000u); }
__device__ __forceinline__ float wsum(float v) {
#pragma unroll
  for (int o = 32; o; o >>= 1) v += __shfl_xor(v, o);
  return v;
}
__device__ __forceinline__ float xh_max(float v) {
  auto rr = __builtin_amdgcn_permlane32_swap(__float_as_uint(v), __float_as_uint(v), false, false);
  return fmaxf(__uint_as_float(rr[0]), __uint_as_float(rr[1]));
}
__device__ __forceinline__ float xh_sum(float v) {
  auto rr = __builtin_amdgcn_permlane32_swap(__float_as_uint(v), __float_as_uint(v), false, false);
  return __uint_as_float(rr[0]) + __uint_as_float(rr[1]);
}
__device__ __forceinline__ float frcp_(float x) { return __builtin_amdgcn_rcpf(x); }
__device__ __forceinline__ float fexp_(float x) { return __builtin_amdgcn_exp2f(x * LOG2E); }
__device__ __forceinline__ float sigmoidf_(float x) { return frcp_(1.f + fexp_(-x)); }
__device__ __forceinline__ float siluf_(float x) { return x * frcp_(1.f + fexp_(-x)); }
__device__ __forceinline__ float log_sigmoidf_(float x) { return fminf(x, 0.f) - log1pf(__expf(-fabsf(x))); }

struct TrDesc { const float* src; u16* dst; const float* ksc; int ld_src, ld_dst; };
__device__ __forceinline__ TrDesc tr_desc(const Params& p, int t) {
  TrDesc d;
  if (t < 3072) {
    const int kt = t & 31, nt = t >> 5, n0 = nt * 64;
    const int sc0 = n0 + (n0 >= 3072 ? 8 : 0);
    d.src = p.w_in + (long)kt * 64 * NIN + sc0; d.ld_src = NIN; d.dst = p.WinT + (long)n0 * KD + kt * 64; d.ld_dst = KD; d.ksc = nullptr;
  } else if (t < 4096) {
    const int u = t - 3072, kt = u & 31, nt = u >> 5;
    d.ksc = (kt < 16) ? (p.ag + kt * 64) : (p.lg + (kt - 16) * 64);
    d.src = p.w_out + (long)kt * 64 * DM + nt * 64; d.ld_src = DM; d.dst = p.WoutT + (long)nt * 64 * KD + kt * 64; d.ld_dst = KD;
  } else {
    const int u = t - 4096, mat = u >> 2, sub = u & 3, kt = sub & 1, nt = sub >> 1;
    const float* sm = (mat < 8) ? (p.w_rg + mat * 16384) : (p.w_ig + (mat - 8) * 16384);
    d.src = sm + kt * 64 * 128 + nt * 64; d.ld_src = 128; d.dst = p.WgT + mat * 16384 + nt * 64 * 128 + kt * 64; d.ld_dst = 128; d.ksc = nullptr;
  }
  return d;
}

__device__ void phase_prep(const Params& p) {
  int tid = threadIdx.x; asm volatile("" : "+v"(tid));
  const int lane = tid & 63, wid = tid >> 6;
  for (int i = blockIdx.x * NTHR + tid; i < 3 * MTOK + 16 + 64; i += gridDim.x * NTHR) p.ssq[i] = 0.f;
  {
    constexpr int NT = 3072 + 1024 + 64;
    float* T = (float*)smem + wid * (64 * 65);
    const int r4 = lane >> 4, c4 = (lane & 15) * 4;
    const int n8 = lane >> 3, k8 = (lane & 7) * 8;
    for (int t = blockIdx.x * 8 + wid; t < NT; t += 8 * gridDim.x) {
      const TrDesc d = tr_desc(p, t);
      f32x4 v[16]; float sc[16];
#pragma unroll
      for (int i = 0; i < 16; ++i) {
        const int rr = i * 4 + r4;
        v[i] = __builtin_nontemporal_load((const f32x4*)(d.src + (long)rr * d.ld_src + c4));
        sc[i] = d.ksc ? d.ksc[rr] : 1.f;
      }
#pragma unroll
      for (int i = 0; i < 16; ++i) {
        const int rr = i * 4 + r4;
        T[rr * 65 + c4 + 0] = v[i][0] * sc[i]; T[rr * 65 + c4 + 1] = v[i][1] * sc[i];
        T[rr * 65 + c4 + 2] = v[i][2] * sc[i]; T[rr * 65 + c4 + 3] = v[i][3] * sc[i];
      }
#pragma unroll
      for (int j = 0; j < 8; ++j) {
        const int n = n8 + 8 * j;
        float tt[8];
#pragma unroll
        for (int i = 0; i < 8; ++i) tt[i] = T[(k8 + i) * 65 + n];
        u32x4 pk = {cvtpk(tt[0], tt[1]), cvtpk(tt[2], tt[3]), cvtpk(tt[4], tt[5]), cvtpk(tt[6], tt[7])};
        *(u32x4*)(d.dst + (long)n * d.ld_dst + k8) = pk;
      }
    }
  }
  __syncthreads();
  f32x4* WF = (f32x4*)smem;
  for (int idx = tid; idx < 4096; idx += NTHR) {
    const int ln = idx & 63, half = (idx >> 6) & 1, e = (idx >> 7) & 3, i = idx >> 9;
    const int k = (i * 64 + ln) * 4 + e;
    WF[idx] = *(const f32x4*)(p.w_in + (long)k * NIN + 3072 + half * 4);
  }
  __syncthreads();
  f32x4 xn[8];
  {
    const f32x4* xr = (const f32x4*)(p.x + (long)(blockIdx.x * 8 + wid) * DM);
#pragma unroll
    for (int i = 0; i < 8; ++i) xn[i] = __builtin_nontemporal_load(xr + i * 64 + lane);
  }
  for (int row = blockIdx.x * 8 + wid; row < MTOK; row += gridDim.x * 8) {
    f32x4 xv[8];
#pragma unroll
    for (int i = 0; i < 8; ++i) xv[i] = xn[i];
    if (row + (int)gridDim.x * 8 < MTOK) {
      const f32x4* xr = (const f32x4*)(p.x + (long)(row + gridDim.x * 8) * DM);
#pragma unroll
      for (int i = 0; i < 8; ++i) xn[i] = __builtin_nontemporal_load(xr + i * 64 + lane);
    }
    float ss = 0.f;
#pragma unroll
    for (int i = 0; i < 8; ++i) ss += xv[i][0] * xv[i][0] + xv[i][1] * xv[i][1] + xv[i][2] * xv[i][2] + xv[i][3] * xv[i][3];
    ss = wsum(ss);
    const float rs = rsqrtf(ss * (1.f / DM) + EPS);
    float f[8];
#pragma unroll
    for (int q = 0; q < 8; ++q) f[q] = 0.f;
#pragma unroll
    for (int i = 0; i < 8; ++i) {
      f32x4 g = ((const f32x4*)p.norm_g)[i * 64 + lane];
      float hv[4];
#pragma unroll
      for (int e = 0; e < 4; ++e) hv[e] = xv[i][e] * rs * g[e];
      u32x2 pk = {cvtpk(hv[0], hv[1]), cvtpk(hv[2], hv[3])};
      *(u32x2*)(p.hb + (long)row * DM + (i * 64 + lane) * 4) = pk;
#pragma unroll
      for (int e = 0; e < 4; ++e) {
        f32x4 wa = WF[((i * 4 + e) * 2 + 0) * 64 + lane], wb = WF[((i * 4 + e) * 2 + 1) * 64 + lane];
        f[0] += hv[e] * wa[0]; f[1] += hv[e] * wa[1]; f[2] += hv[e] * wa[2]; f[3] += hv[e] * wa[3];
        f[4] += hv[e] * wb[0]; f[5] += hv[e] * wb[1]; f[6] += hv[e] * wb[2]; f[7] += hv[e] * wb[3];
      }
      __builtin_amdgcn_sched_barrier(0);
    }
#pragma unroll
    for (int q = 0; q < 8; ++q) f[q] = wsum(f[q]);
    if (lane == 0) {
      const int b = row / SEQ, s = row % SEQ;
#pragma unroll
      for (int q = 0; q < 8; ++q) p.logf[(b * NH + q) * SEQ + s] = log_sigmoidf_(f[q] + p.b_f[q]);
    }
  }
  __syncthreads();
}

constexpr int BM = 256, BK = 64, HALF = 128, HT = HALF * BK;
constexpr int SHM_BYTES = 8 * HT * 2;
constexpr int SHM_TOTAL = 8 * 32 * 132 * 4;

__device__ __forceinline__ int lds_byte(int r, int c) {
  int st = (r >> 4) * 2 + (c >> 5), rr = r & 15, cc = c & 31, ob = rr * 64 + cc * 2;
  return st * 1024 + (ob ^ (((ob >> 9) & 1) << 5));
}
__device__ __forceinline__ void stage_rc(int b, int& R, int& C) {
  int st = b / 1024, sb = b % 1024, swz = sb ^ (((sb >> 9) & 1) << 5);
  R = (st >> 1) * 16 + swz / 64; C = (st & 1) * 32 + (swz % 64) / 2;
}

#define SA(b, h) ((u16*)smem + ((b) * 2 + (h)) * HT)
#define SB(b, h) ((u16*)smem + (4 + (b) * 2 + (h)) * HT)
#define STAGE(P, BASE, br, kt) do { const char* _u = (const char*)((BASE) + (long)(br) * KD + (long)(kt) * BK); \
    __builtin_amdgcn_global_load_lds((const unsigned*)(_u + soff0), (unsigned*)((char*)(P) + gtid * 16), 16, 0, 0); \
    __builtin_amdgcn_global_load_lds((const unsigned*)(_u + soff1), (unsigned*)((char*)(P) + gtid * 16 + 8192), 16, 0, 0); } while (0)
#define LDA(dst, b, h) for (int m = 0; m < 4; ++m) for (int k = 0; k < 2; ++k) \
    dst[m][k] = *reinterpret_cast<const bf16x8*>((char*)SA(b, h) + lds_byte(wr * 64 + m * 16 + fr, k * 32 + fq * 8))
#define LDB(dst, b, h) for (int n = 0; n < 2; ++n) for (int k = 0; k < 2; ++k) \
    dst[n][k] = *reinterpret_cast<const bf16x8*>((char*)SB(b, h) + lds_byte(wc * 32 + n * 16 + fr, k * 32 + fq * 8))
#define MMA(ai, bj, At, Bt_) do { __builtin_amdgcn_s_setprio(1); \
    for (int m = 0; m < 4; ++m) for (int n = 0; n < 2; ++n) for (int k = 0; k < 2; ++k) \
      acc[ai][bj][m][n] = __builtin_amdgcn_mfma_f32_16x16x32_bf16(Bt_[n][k], At[m][k], acc[ai][bj][m][n], 0, 0, 0); \
    __builtin_amdgcn_s_setprio(0); } while (0)
#define WAIT_V(n) asm volatile("s_waitcnt vmcnt(" #n ")" ::: "memory")
#define WAIT_L(n) asm volatile("s_waitcnt lgkmcnt(" #n ")" ::: "memory")
#define BAR __builtin_amdgcn_s_barrier()
#define SCHED __builtin_amdgcn_sched_barrier(0)

template <bool MID>
__device__ __forceinline__ void gemm_core(const u16* __restrict__ A, const u16* __restrict__ Bt, const int brow, const int bcol,
                                          f32x4 (&acc)[2][2][4][2], const float* __restrict__ ssq) {
  int gtid = threadIdx.x; asm volatile("" : "+v"(gtid));
  const int wid = gtid >> 6, lane = gtid & 63, wr = wid >> 2, wc = wid & 3, fr = lane & 15, fq = lane >> 4;
  unsigned soff0, soff1;
  { int r_, c_; stage_rc(gtid * 16, r_, c_); soff0 = (unsigned)(r_ * KD + c_) * 2u; stage_rc(gtid * 16 + 8192, r_, c_); soff1 = (unsigned)(r_ * KD + c_) * 2u; }
  bf16x8 At[4][2], B0[2][2], B1[2][2];
  constexpr int nt = KD / BK;
  STAGE(SB(0, 0), Bt, bcol, 0); STAGE(SA(0, 0), A, brow, 0);
  STAGE(SB(0, 1), Bt, bcol + HALF, 0); STAGE(SA(0, 1), A, brow + HALF, 0);
  if (wr == 1) BAR;
  WAIT_V(4); BAR;
  STAGE(SB(1, 0), Bt, bcol, 1); STAGE(SA(1, 0), A, brow, 1); STAGE(SB(1, 1), Bt, bcol + HALF, 1);
  WAIT_V(6); BAR;
  for (int t = 0; t < nt - 2; t += 2) {
    if (MID && t == 16) {
      const float* rt_ = (const float*)(smem + SHM_BYTES);
#pragma unroll
      for (int ai = 0; ai < 2; ++ai)
#pragma unroll
        for (int m = 0; m < 4; ++m) {
          const float ratio = rt_[ai * HALF + wr * 64 + m * 16 + fr];
#pragma unroll
          for (int bj = 0; bj < 2; ++bj)
#pragma unroll
            for (int n = 0; n < 2; ++n)
#pragma unroll
              for (int j = 0; j < 4; ++j) acc[ai][bj][m][n][j] *= ratio;
        }
    }
    LDB(B0, 0, 0); SCHED; LDA(At, 0, 0); STAGE(SA(1, 1), A, brow + HALF, t + 1);
    WAIT_L(8); BAR; WAIT_L(0); MMA(0, 0, At, B0); BAR; SCHED;
    LDB(B1, 0, 1); STAGE(SB(0, 0), Bt, bcol, t + 2);
    BAR; WAIT_L(0); MMA(0, 1, At, B1); BAR;
    LDA(At, 0, 1); STAGE(SA(0, 0), A, brow, t + 2);
    BAR; WAIT_L(0); MMA(1, 0, At, B0); BAR; SCHED;
    STAGE(SB(0, 1), Bt, bcol + HALF, t + 2);
    WAIT_V(6); BAR; MMA(1, 1, At, B1); BAR;
    LDB(B0, 1, 0); SCHED; LDA(At, 1, 0); STAGE(SA(0, 1), A, brow + HALF, t + 2);
    WAIT_L(8); BAR; WAIT_L(0); MMA(0, 0, At, B0); BAR; SCHED;
    LDB(B1, 1, 1); STAGE(SB(1, 0), Bt, bcol, t + 3);
    BAR; WAIT_L(0); MMA(0, 1, At, B1); BAR;
    LDA(At, 1, 1); STAGE(SA(1, 0), A, brow, t + 3);
    BAR; WAIT_L(0); MMA(1, 0, At, B0); BAR; SCHED;
    STAGE(SB(1, 1), Bt, bcol + HALF, t + 3);
    WAIT_V(6); BAR; MMA(1, 1, At, B1); BAR;
  }
  { LDB(B0, 0, 0); LDA(At, 0, 0); STAGE(SA(1, 1), A, brow + HALF, nt - 1);
    BAR; WAIT_L(0); MMA(0, 0, At, B0); BAR;
    LDB(B1, 0, 1); BAR; WAIT_L(0); MMA(0, 1, At, B1); BAR;
    LDA(At, 0, 1); WAIT_V(4); BAR; WAIT_L(0); MMA(1, 0, At, B0); MMA(1, 1, At, B1); BAR; }
  { LDB(B0, 1, 0); LDA(At, 1, 0); WAIT_V(2); BAR; WAIT_L(0); MMA(0, 0, At, B0); BAR;
    LDB(B1, 1, 1); WAIT_V(0); BAR; WAIT_L(0); MMA(0, 1, At, B1); BAR;
    LDA(At, 1, 1); BAR; WAIT_L(0); MMA(1, 0, At, B0); MMA(1, 1, At, B1); BAR; }
  if (wr == 0) BAR;
}

__device__ __forceinline__ void tile_map(int round, int nPatchN, int& pm, int& pn) {
  const int xcd = blockIdx.x & 7, local = blockIdx.x >> 3;
  const int patch = round * 8 + xcd;
  const int pmm = patch / nPatchN, pnn = patch % nPatchN;
  pm = pmm * 4 + (local & 3); pn = pnn * 8 + (local >> 2);
}

__device__ void phase_inproj(const Params& p) {
  for (int round = 0; round < 6; ++round) {
    int pm, pn; tile_map(round, 3, pm, pn);
    const int brow = pm * BM, bcol = pn * BM;
    f32x4 acc[2][2][4][2] = {};
    gemm_core<false>(p.hb, p.WinT, brow, bcol, acc, nullptr);
    __syncthreads();
    int tid = threadIdx.x; asm volatile("" : "+v"(tid));
    const int wid = tid >> 6, lane = tid & 63, wr = wid >> 2, wc = wid & 3, fr = lane & 15, fq = lane >> 4;
    const int region = pn >> 2;
    const int cofs = (pn & 3) * 256;
    const float osc = (region == 0) ? QSCALE : 1.f;
    u16* C16 = (u16*)smem;
    float kn2 = 0.f;
#pragma unroll
    for (int ai = 0; ai < 2; ++ai) {
      if (region != 2) {
#pragma unroll
        for (int bj = 0; bj < 2; ++bj)
#pragma unroll
          for (int m = 0; m < 4; ++m)
#pragma unroll
            for (int n = 0; n < 2; ++n) {
              const int r = wr * 64 + m * 16 + fr, c = bj * 128 + wc * 32 + n * 16 + fq * 4;
              u32x2 pk = {cvtpk(acc[ai][bj][m][n][0] * osc, acc[ai][bj][m][n][1] * osc), cvtpk(acc[ai][bj][m][n][2] * osc, acc[ai][bj][m][n][3] * osc)};
              *(u32x2*)(C16 + r * 264 + c) = pk;
            }
        __syncthreads();
        u16* dst = (region == 0) ? p.qb : (region == 1) ? p.kb : (region == 3) ? p.za : (region == 4) ? p.xl : p.zl;
#pragma unroll
        for (int i = 0; i < 8; ++i) {
          const int id = tid + NTHR * i, r = id >> 5, c8 = (id & 31) * 8;
          u32x4 v = *(const u32x4*)(C16 + r * 264 + c8);
          *(u32x4*)(dst + (long)(brow + ai * HALF + r) * 1024 + cofs + c8) = v;
          if (region == 1) {
            float s2 = 0.f;
#pragma unroll
            for (int e = 0; e < 4; ++e) { const float a = bflo(v[e]), bq = bfhi(v[e]); s2 += a * a + bq * bq; }
            s2 += __shfl_xor(s2, 1); s2 += __shfl_xor(s2, 2); s2 += __shfl_xor(s2, 4); s2 += __shfl_xor(s2, 8);
            kn2 = fmaxf(kn2, s2);
          }
        }
      } else {
#pragma unroll
        for (int bj = 0; bj < 2; ++bj)
#pragma unroll
          for (int m = 0; m < 4; ++m)
#pragma unroll
            for (int n = 0; n < 2; ++n) {
              const int r = wr * 64 + m * 16 + fr, c = bj * 128 + wc * 32 + n * 16 + fq * 4;
#pragma unroll
              for (int j = 0; j < 4; ++j) C16[(c + j) * 136 + r] = (u16)cvtpk(acc[ai][bj][m][n][j], 0.f);
            }
        __syncthreads();
        const int b = brow / SEQ, s0 = brow % SEQ + ai * HALF;
#pragma unroll
        for (int i = 0; i < 8; ++i) {
          const int id = tid + NTHR * i, c = id >> 4, r8 = (id & 15) * 8;
          u32x4 v = *(const u32x4*)(C16 + c * 136 + r8);
          const int head = (pn & 3) * 2 + (c >> 7), d = c & 127;
          *(u32x4*)(p.vT + ((long)(b * NH + head) * HD + d) * SEQ + s0 + r8) = v;
        }
      }
      __syncthreads();
    }
    if (region == 1) {
      kn2 = fmaxf(kn2, __shfl_xor(kn2, 32));
      if ((lane & 47) == 0)
        atomicMax((unsigned*)p.ssq + 3 * MTOK + (brow / SEQ) * NH + (pn & 3) * 2 + ((lane >> 4) & 1), __float_as_uint(kn2));
    }
  }
}

__device__ void cumsum_item(const Params& p, int bh) {
  int tid = threadIdx.x; asm volatile("" : "+v"(tid));
  const int lane = tid & 63, wid = tid >> 6;
  float* wtot = (float*)smem;
  const float* src = p.logf + bh * SEQ + tid * 16;
  float v[16];
#pragma unroll
  for (int i = 0; i < 4; ++i) { f32x4 t = *(const f32x4*)(src + i * 4); v[i * 4] = t[0]; v[i * 4 + 1] = t[1]; v[i * 4 + 2] = t[2]; v[i * 4 + 3] = t[3]; }
#pragma unroll
  for (int i = 1; i < 16; ++i) v[i] += v[i - 1];
  float tot = v[15], inc = tot;
#pragma unroll
  for (int o = 1; o < 64; o <<= 1) { float u = __shfl_up(inc, o); if (lane >= o) inc += u; }
  if (lane == 63) wtot[wid] = inc;
  __syncthreads();
  float base = inc - tot;
  for (int w = 0; w < wid; ++w) base += wtot[w];
  float* dst = p.c2 + bh * SEQ + tid * 16;
#pragma unroll
  for (int i = 0; i < 4; ++i) {
    f32x4 t = {(v[i * 4] + base) * LOG2E, (v[i * 4 + 1] + base) * LOG2E, (v[i * 4 + 2] + base) * LOG2E, (v[i * 4 + 3] + base) * LOG2E};
    *(f32x4*)(dst + i * 4) = t;
  }
  __syncthreads();
}

template <int PASS>
__device__ void lru_phase(const Params& p) {
  int tid = threadIdx.x; asm volatile("" : "+v"(tid));
  const int lane = tid & 63, w = tid >> 6, fr = lane & 15, fq = lane >> 4;
  const int nb = blockIdx.x & 7, c0 = blockIdx.x >> 3;
  u16* Ub = (u16*)smem;
  float* U32 = (float*)(smem + 17408);
  float* Ab = (float*)(smem + 50176);
  float* Bb = (float*)(smem + 82944);
  float* sgA = (float*)(smem + 115712);
  float* sgH = sgA + 512;
  const float* CY = (const float*)(smem + 126976);
  bf16x8 bR[4], bI[4];
  {
    const u16* wr_ = p.WgT + (long)nb * 16384 + (w * 16 + fr) * 128 + fq * 8;
    const u16* wi_ = p.WgT + (long)(8 + nb) * 16384 + (w * 16 + fr) * 128 + fq * 8;
#pragma unroll
    for (int ks = 0; ks < 4; ++ks) { bR[ks] = *(const bf16x8*)(wr_ + ks * 32); bI[ks] = *(const bf16x8*)(wi_ + ks * 32); }
  }
  const int c8 = (tid & 15) * 8, tr = tid >> 4, gc = nb * 128 + c8;
  float cw[4][8], cb[8];
#pragma unroll
  for (int k = 0; k < 4; ++k) {
    f32x4 a = *(const f32x4*)(p.conv_w + k * LW + gc), bq = *(const f32x4*)(p.conv_w + k * LW + gc + 4);
    cw[k][0] = a[0]; cw[k][1] = a[1]; cw[k][2] = a[2]; cw[k][3] = a[3]; cw[k][4] = bq[0]; cw[k][5] = bq[1]; cw[k][6] = bq[2]; cw[k][7] = bq[3];
  }
  { f32x4 a = *(const f32x4*)(p.conv_b + gc), bq = *(const f32x4*)(p.conv_b + gc + 4);
    cb[0] = a[0]; cb[1] = a[1]; cb[2] = a[2]; cb[3] = a[3]; cb[4] = bq[0]; cb[5] = bq[1]; cb[6] = bq[2]; cb[7] = bq[3]; }
  const int chE = w * 16 + fr, gchE = nb * 128 + chE;
  const float br = p.b_rg[gchE], bi = p.b_ig[gchE];
  const float sp = log1pf(__expf(-p.lam[gchE]));
  const int ch = tid & 127, seg = tid >> 7;
  const int to = tid >> 3, c16 = (tid & 7) * 16;
  u32x4 xr[2][4];
#define LRU_PREFETCH(i_) do { const int b_ = (i_) >> 2, s0_ = (c0 + 32 * ((i_) & 3)) * CHUNK; const long tokb_ = (long)b_ * SEQ; \
    _Pragma("unroll") for (int tt = 0; tt < 2; ++tt) _Pragma("unroll") for (int k = 0; k < 4; ++k) { \
      const int sp_ = s0_ + tr + tt * 32 - 3 + k; u32x4 z_ = {0u, 0u, 0u, 0u}; \
      xr[tt][k] = (sp_ >= 0) ? __builtin_nontemporal_load((const u32x4*)(p.xl + (tokb_ + sp_) * LW + gc)) : z_; } \
    } while (0)
  LRU_PREFETCH(0);
#pragma unroll 1
  for (int it = 0; it < 8; ++it) {
    const int b = it >> 2, chunk = c0 + 32 * (it & 3), s0 = chunk * CHUNK;
    const long tokb = (long)b * SEQ;
    u32x4 z0, z1;
    if (PASS == 2) { const u16* zp_ = p.zl + (tokb + s0 + to) * LW + nb * 128 + c16; z0 = __builtin_nontemporal_load((const u32x4*)zp_); z1 = __builtin_nontemporal_load((const u32x4*)(zp_ + 8)); }
#pragma unroll
    for (int tt = 0; tt < 2; ++tt) {
      const int t = tr + tt * 32;
      f2_t u2[4];
#pragma unroll
      for (int e = 0; e < 4; ++e) { f2_t c_ = {cb[2 * e], cb[2 * e + 1]}; u2[e] = c_; }
#pragma unroll
      for (int k = 0; k < 4; ++k)
#pragma unroll
        for (int e = 0; e < 4; ++e) {
          f2_t w_ = {cw[k][2 * e], cw[k][2 * e + 1]}, x_ = {bflo(xr[tt][k][e]), bfhi(xr[tt][k][e])};
          u2[e] = w_ * x_ + u2[e];
        }
      f32x4 u0 = {u2[0][0], u2[0][1], u2[1][0], u2[1][1]}, u1 = {u2[2][0], u2[2][1], u2[3][0], u2[3][1]};
      *(f32x4*)(U32 + t * 128 + c8) = u0; *(f32x4*)(U32 + t * 128 + c8 + 4) = u1;
      u32x4 pk = {cvtpk(u2[0][0], u2[0][1]), cvtpk(u2[1][0], u2[1][1]), cvtpk(u2[2][0], u2[2][1]), cvtpk(u2[3][0], u2[3][1])};
      *(u32x4*)(Ub + t * 136 + c8) = pk;
    }
    if (it + 1 < 8) LRU_PREFETCH(it + 1);
    __syncthreads();
    f32x4 aR[4] = {}, aI[4] = {};
    {
      bf16x8 af[4];
#define ALD(i) af[(i) & 3] = *(const bf16x8*)(Ub + (((i) & 3) * 16 + fr) * 136 + ((i) >> 2) * 32 + fq * 8)
      ALD(0); ALD(1); ALD(2);
#pragma unroll
      for (int i = 0; i < 16; ++i) {
        if (i + 3 < 16) ALD(i + 3);
        aR[i & 3] = __builtin_amdgcn_mfma_f32_16x16x32_bf16(af[i & 3], bR[i >> 2], aR[i & 3], 0, 0, 0);
        aI[i & 3] = __builtin_amdgcn_mfma_f32_16x16x32_bf16(af[i & 3], bI[i >> 2], aI[i & 3], 0, 0, 0);
        __builtin_amdgcn_sched_barrier(0);
      }
#undef ALD
    }
    {
      const f2_t nl2 = {-LOG2E, -LOG2E}, one = {1.f, 1.f};
      const f2_t brs = {br * -LOG2E, br * -LOG2E}, bis = {bi * -LOG2E, bi * -LOG2E};
      const float c1s = -8.f * sp * LOG2E;
      const f2_t c1 = {c1s, c1s};
#pragma unroll
      for (int m = 0; m < 4; ++m)
#pragma unroll
        for (int j = 0; j < 4; j += 2) {
          const int t = m * 16 + fq * 4 + j;
          f2_t xr2 = {aR[m][j], aR[m][j + 1]}, xi2 = {aI[m][j], aI[m][j + 1]};
          f2_t tr2 = xr2 * nl2 + brs, ti2 = xi2 * nl2 + bis;
          f2_t e1 = {__builtin_amdgcn_exp2f(tr2[0]), __builtin_amdgcn_exp2f(tr2[1])};
          f2_t e2 = {__builtin_amdgcn_exp2f(ti2[0]), __builtin_amdgcn_exp2f(ti2[1])};
          f2_t d1 = e1 + one, d2 = e2 + one;
          f2_t r2 = {__builtin_amdgcn_rcpf(d1[0]), __builtin_amdgcn_rcpf(d1[1])};
          f2_t ig2 = {__builtin_amdgcn_rcpf(d2[0]), __builtin_amdgcn_rcpf(d2[1])};
          f2_t ta = r2 * c1;
          f2_t a2 = {__builtin_amdgcn_exp2f(ta[0]), __builtin_amdgcn_exp2f(ta[1])};
          f2_t om = one - a2 * a2;
          f2_t mu = {__builtin_amdgcn_sqrtf(om[0]), __builtin_amdgcn_sqrtf(om[1])};
          f2_t uu = {U32[t * 128 + chE], U32[(t + 1) * 128 + chE]};
          f2_t bt = mu * ig2 * uu;
          Ab[t * 128 + chE] = a2[0]; Ab[(t + 1) * 128 + chE] = a2[1];
          Bb[t * 128 + chE] = bt[0]; Bb[(t + 1) * 128 + chE] = bt[1];
        }
    }
    __syncthreads();
    {
      float A = 1.f, H = 0.f;
#pragma unroll
      for (int i = 0; i < 16; ++i) { const int t = seg * 16 + i; const float a = Ab[t * 128 + ch]; H = a * H + Bb[t * 128 + ch]; A *= a; }
      sgA[seg * 128 + ch] = A; sgH[seg * 128 + ch] = H;
    }
    __syncthreads();
    if (PASS == 1) {
      if (tid < 128) {
        float A = 1.f, H = 0.f;
#pragma unroll
        for (int s = 0; s < 4; ++s) { const float a = sgA[s * 128 + ch]; H = a * H + sgH[s * 128 + ch]; A *= a; }
        const unsigned oi = (unsigned)((b * NCHUNK + chunk) * LW + nb * 128 + ch);
        p.lruA[oi] = A;
        p.lruH[oi] = H;
      }
    } else {
      float H = CY[it * 128 + ch];
#pragma unroll
      for (int s = 0; s < 3; ++s) if (s < seg) H = sgA[s * 128 + ch] * H + sgH[s * 128 + ch];
#pragma unroll
      for (int i = 0; i < 16; ++i) { const int t = seg * 16 + i; H = Ab[t * 128 + ch] * H + Bb[t * 128 + ch]; Bb[t * 128 + ch] = H; }
      __syncthreads();
      const long tok = tokb + s0 + to;
      float h[16], ss = 0.f;
#pragma unroll
      for (int i = 0; i < 4; ++i) { f32x4 v = *(const f32x4*)(Bb + to * 128 + c16 + i * 4); h[i * 4] = v[0]; h[i * 4 + 1] = v[1]; h[i * 4 + 2] = v[2]; h[i * 4 + 3] = v[3]; }
#pragma unroll
      for (int i = 0; i < 16; ++i) ss += h[i] * h[i];
      ss += __shfl_xor(ss, 1); ss += __shfl_xor(ss, 2); ss += __shfl_xor(ss, 4);
      if ((tid & 7) == 0) atomicAdd(p.ssq + MTOK + tok, ss);
      unsigned o[8];
#pragma unroll
      for (int i = 0; i < 8; ++i) {
        const unsigned zw = (i < 4) ? z0[i & 3] : z1[i & 3];
        const f2_t z2 = {bflo(zw), bfhi(zw)}, h2 = {h[2 * i], h[2 * i + 1]}, nl2 = {-LOG2E, -LOG2E}, one = {1.f, 1.f};
        const f2_t t2 = z2 * nl2;
        const f2_t e2 = {__builtin_amdgcn_exp2f(t2[0]), __builtin_amdgcn_exp2f(t2[1])};
        const f2_t d2 = e2 + one;
        const f2_t iv = {__builtin_amdgcn_rcpf(d2[0]), __builtin_amdgcn_rcpf(d2[1])};
        const f2_t ov = h2 * z2 * iv;
        o[i] = cvtpk(ov[0], ov[1]);
      }
      u16* op = p.mixed + tok * DM + AW + nb * 128 + c16;
      u32x4 o0 = {o[0], o[1], o[2], o[3]}, o1 = {o[4], o[5], o[6], o[7]};
      *(u32x4*)op = o0; *(u32x4*)(op + 8) = o1;
    }
  }
  __syncthreads();
#undef LRU_PREFETCH
}

__device__ void lru_carry_block(const Params& p) {
  float* CY = (float*)(smem + 126976);
  float* TA = (float*)smem;
  float* TH = TA + 512;
  int tid = threadIdx.x; asm volatile("" : "+v"(tid));
  const int ch = tid & 127, sg = tid >> 7;
  const int nb = blockIdx.x & 7, c0 = blockIdx.x >> 3;
  const int lo = (sg == 0) ? 0 : c0 + 32 * (sg - 1), hi = c0 + 32 * sg;
  float av[NB][32], hv[NB][32];
#pragma unroll
  for (int b = 0; b < NB; ++b) {
    const float* pa = p.lruA + ((long)b * NCHUNK) * LW + nb * 128 + ch;
    const float* ph = p.lruH + ((long)b * NCHUNK) * LW + nb * 128 + ch;
#pragma unroll
    for (int u = 0; u < 32; ++u) {
      const int c = lo + u;
      const bool ok = c < hi;
      av[b][u] = ok ? pa[(long)c * LW] : 1.f;
      hv[b][u] = ok ? ph[(long)c * LW] : 0.f;
    }
  }
#pragma unroll
  for (int b = 0; b < NB; ++b) {
    float A = 1.f, H = 0.f;
#pragma unroll
    for (int u = 0; u < 32; ++u) { H = av[b][u] * H + hv[b][u]; A *= av[b][u]; }
    TA[sg * 128 + ch] = A; TH[sg * 128 + ch] = H;
    __syncthreads();
    if (tid < 128) {
      float Hc = 0.f;
#pragma unroll
      for (int i = 0; i < 4; ++i) { Hc = TA[i * 128 + ch] * Hc + TH[i * 128 + ch]; CY[(b * 4 + i) * 128 + ch] = Hc; }
    }
    __syncthreads();
  }
}

__device__ void attn_item(const Params& p, int b, int h, int qblk) {
  int tid = threadIdx.x; asm volatile("" : "+v"(tid));
  const int lane = tid & 63, w = tid >> 6, c = lane & 31, hi = lane >> 5;
  char* Kl = smem;
  char* Vl = smem + 34816;
  float* Cl = (float*)(smem + 69632);
  const int P0 = qblk * 256;
  const int qrow = P0 + w * 32 + c;
  const long tokb = (long)b * SEQ;
  const int bh = b * NH + h;
  bf16x8 qf[8];
  {
    const u16* qp = p.qb + (tokb + qrow) * AW + h * HD + hi * 8;
#pragma unroll
    for (int d0 = 0; d0 < 8; ++d0) qf[d0] = *(const bf16x8*)(qp + d0 * 16);
  }
  const float* c2 = p.c2 + (long)bh * SEQ;
  float* Wm = (float*)(smem + 69632 + 512);
  float ebase;
  {
    float q2 = 0.f;
#pragma unroll
    for (int d0 = 0; d0 < 8; ++d0) {
      u32x4 t = __builtin_bit_cast(u32x4, qf[d0]);
#pragma unroll
      for (int e = 0; e < 4; ++e) { const float a = bflo(t[e]), bq = bfhi(t[e]); q2 += a * a + bq * bq; }
    }
    q2 = xh_sum(q2);
    const float kmax = sqrtf(__uint_as_float(((const unsigned*)p.ssq)[3 * MTOK + bh])) * 1.001f;
    ebase = sqrtf(q2) * 1.001f * kmax;
  }
  constexpr float T2 = 40.f;
  f32x16 o[4];
#pragma unroll
  for (int dt = 0; dt < 4; ++dt)
#pragma unroll
    for (int r = 0; r < 16; ++r) o[dt][r] = 0.f;
  float mrun = -1e30f, lrun = 0.f, ewave = __builtin_inff();
  const int jhi = 4 * qblk + 3;
  const int kkey = tid >> 3, kc = (tid & 7) * 16;
  const int vd = tid >> 2, vk = (tid & 3) * 16;
  const u16* kg = p.kb + (tokb + kkey) * AW + h * HD + kc;
  const u16* vg = p.vT + ((long)bh * HD + vd) * SEQ + vk;
  u32x4 sk0A, sk1A, sv0A, sv1A, sk0B, sk1B, sv0B, sv1B; float scA = 0.f, scB = 0.f;
#define AT_GLOAD(S, j) do { const u16* kp_ = kg + (long)(j) * 64 * AW; sk0##S = *(const u32x4*)kp_; sk1##S = *(const u32x4*)(kp_ + 8); \
    const u16* vp_ = vg + (j) * 64; sv0##S = *(const u32x4*)vp_; sv1##S = *(const u32x4*)(vp_ + 8); if (tid < 64) sc##S = c2[(j) * 64 + tid]; } while (0)
#define AT_LSTORE(S, bf) do { char* kd_ = Kl + (bf) * 17408 + kkey * 272 + kc * 2; *(u32x4*)kd_ = sk0##S; *(u32x4*)(kd_ + 16) = sk1##S; \
    char* vd_ = Vl + (bf) * 17408 + vd * 136 + vk * 2; u32x2 a0_ = {sv0##S[0], sv0##S[1]}, a1_ = {sv0##S[2], sv0##S[3]}, a2_ = {sv1##S[0], sv1##S[1]}, a3_ = {sv1##S[2], sv1##S[3]}; \
    *(u32x2*)vd_ = a0_; *(u32x2*)(vd_ + 8) = a1_; *(u32x2*)(vd_ + 16) = a2_; *(u32x2*)(vd_ + 24) = a3_; if (tid < 64) Cl[(bf) * 64 + tid] = -sc##S; } while (0)
  AT_GLOAD(A, jhi);
  AT_GLOAD(B, jhi - 1);
  AT_LSTORE(A, 0);
  AT_GLOAD(A, jhi - 2);
  __syncthreads();
  auto tile_body = [&](const int buf, const int j, const int it) __attribute__((always_inline)) {
    const int k0 = 64 * j;
    if (k0 <= P0 + w * 32 + 31 && !(ewave + Cl[buf * 64 + 63] <= -T2)) {
      f32x16 p0, p1;
      {
        const float* ck = Cl + buf * 64 + 4 * hi;
#pragma unroll
        for (int g = 0; g < 4; ++g) {
          f32x4 v0 = *(const f32x4*)(ck + 8 * g), v1 = *(const f32x4*)(ck + 32 + 8 * g);
#pragma unroll
          for (int e = 0; e < 4; ++e) { p0[4 * g + e] = v0[e]; p1[4 * g + e] = v1[e]; }
        }
      }
      const char* kb_ = Kl + buf * 17408 + c * 272 + hi * 16;
      {
        bf16x8 kf[4][2];
#define KLD(d) do { kf[(d) & 3][0] = *(const bf16x8*)(kb_ + (d) * 32); kf[(d) & 3][1] = *(const bf16x8*)(kb_ + 32 * 272 + (d) * 32); } while (0)
        KLD(0); KLD(1); KLD(2);
#pragma unroll
        for (int d0 = 0; d0 < 8; ++d0) {
          if (d0 + 3 < 8) KLD(d0 + 3);
          p0 = __builtin_amdgcn_mfma_f32_32x32x16_bf16(kf[d0 & 3][0], qf[d0], p0, 0, 0, 0);
          p1 = __builtin_amdgcn_mfma_f32_32x32x16_bf16(kf[d0 & 3][1], qf[d0], p1, 0, 0, 0);
          __builtin_amdgcn_sched_barrier(0);
        }
#undef KLD
      }
      if (k0 + 63 > P0 + w * 32) {
        const float NEG = -__builtin_inff();
#pragma unroll
        for (int r = 0; r < 16; ++r) {
          const int key = k0 + (r & 3) + 8 * (r >> 2) + 4 * hi;
          if (key > qrow) p0[r] = NEG;
          if (key + 32 > qrow) p1[r] = NEG;
        }
      }
      float mx;
      {
        f32x16 mv = __builtin_elementwise_max(p0, p1);
        float m8[8];
#pragma unroll
        for (int r = 0; r < 8; ++r) m8[r] = fmaxf(mv[r], mv[r + 8]);
        mx = fmaxf(fmaxf(fmaxf(m8[0], m8[1]), fmaxf(m8[2], m8[3])), fmaxf(fmaxf(m8[4], m8[5]), fmaxf(m8[6], m8[7])));
      }
      mx = xh_max(mx);
      const float mn = fmaxf(mrun, mx);
      const float alpha = __builtin_amdgcn_exp2f(mrun - mn);
      mrun = mn;
      const bool moved = !__all(alpha == 1.f);
      if (moved) {
        float e = ebase - mn;
        e = fmaxf(e, __shfl_xor(e, 16)); e = fmaxf(e, __shfl_xor(e, 8)); e = fmaxf(e, __shfl_xor(e, 4));
        e = fmaxf(e, __shfl_xor(e, 2)); e = fmaxf(e, __shfl_xor(e, 1));
        ewave = e;
      }
      float ps;
      {
        p0 = p0 - mn; p1 = p1 - mn;
#pragma unroll
        for (int r = 0; r < 16; ++r) { p0[r] = __builtin_amdgcn_exp2f(p0[r]); p1[r] = __builtin_amdgcn_exp2f(p1[r]); }
        f32x16 sv = p0 + p1;
        f2_t s2 = {0.f, 0.f};
#pragma unroll
        for (int r = 0; r < 16; r += 2) { f2_t t_ = {sv[r], sv[r + 1]}; s2 += t_; }
        ps = s2[0] + s2[1];
      }
      ps = xh_sum(ps);
      lrun = lrun * alpha + ps;
      if (moved) {
#pragma unroll
        for (int dt = 0; dt < 4; ++dt)
#pragma unroll
          for (int r = 0; r < 16; ++r) o[dt][r] *= alpha;
      }
      bf16x8 pb[4];
      { u32x4 t0 = {cvtpk(p0[0], p0[1]), cvtpk(p0[2], p0[3]), cvtpk(p0[4], p0[5]), cvtpk(p0[6], p0[7])};
        u32x4 t1 = {cvtpk(p0[8], p0[9]), cvtpk(p0[10], p0[11]), cvtpk(p0[12], p0[13]), cvtpk(p0[14], p0[15])};
        u32x4 t2 = {cvtpk(p1[0], p1[1]), cvtpk(p1[2], p1[3]), cvtpk(p1[4], p1[5]), cvtpk(p1[6], p1[7])};
        u32x4 t3 = {cvtpk(p1[8], p1[9]), cvtpk(p1[10], p1[11]), cvtpk(p1[12], p1[13]), cvtpk(p1[14], p1[15])};
        pb[0] = __builtin_bit_cast(bf16x8, t0); pb[1] = __builtin_bit_cast(bf16x8, t1);
        pb[2] = __builtin_bit_cast(bf16x8, t2); pb[3] = __builtin_bit_cast(bf16x8, t3); }
      const char* vb_ = Vl + buf * 17408 + c * 136 + hi * 8;
      {
        u32x4 vv[4];
#define VLD(i) do { const char* a_ = vb_ + ((i) & 3) * 4352 + ((i) >> 2) * 32; u32x2 lo_ = *(const u32x2*)a_, hh_ = *(const u32x2*)(a_ + 16); \
          u32x4 t_ = {lo_[0], lo_[1], hh_[0], hh_[1]}; vv[(i) & 3] = t_; } while (0)
        VLD(0); VLD(1); VLD(2);
#pragma unroll
        for (int i = 0; i < 16; ++i) {
          if (i + 3 < 16) VLD(i + 3);
          o[i & 3] = __builtin_amdgcn_mfma_f32_32x32x16_bf16(__builtin_bit_cast(bf16x8, vv[i & 3]), pb[i >> 2], o[i & 3], 0, 0, 0);
          __builtin_amdgcn_sched_barrier(0);
        }
#undef VLD
      }
    }
    if (lane == 0 && k0 <= P0 + w * 32 + 31) Wm[(it & 1) * 8 + w] = ewave;
  };
#define AT_EXIT(buf_, it_) ((it_) >= 4 && ({ const float* wm = Wm + (((it_) - 1) & 1) * 8; \
      fmaxf(fmaxf(fmaxf(wm[0], wm[1]), fmaxf(wm[2], wm[3])), fmaxf(fmaxf(wm[4], wm[5]), fmaxf(wm[6], wm[7]))); }) + Cl[(buf_) * 64 + 63] <= -T2)
  int it = 0, j = jhi;
  for (;;) {
    if (AT_EXIT(0, it)) break;
    if (j > 0) AT_LSTORE(B, 1);
    if (j > 2) AT_GLOAD(B, j - 3);
    tile_body(0, j, it);
    __syncthreads();
    --j; ++it;
    if (j < 0) break;
    if (AT_EXIT(1, it)) break;
    if (j > 0) AT_LSTORE(A, 0);
    if (j > 2) AT_GLOAD(A, j - 3);
    tile_body(1, j, it);
    __syncthreads();
    --j; ++it;
    if (j < 0) break;
  }
#undef AT_EXIT
#undef AT_GLOAD
#undef AT_LSTORE
  u32x4 zz8[8];
#pragma unroll
  for (int i = 0; i < 8; ++i) {
    const int id = lane + 64 * i, row = id >> 4, d8 = (id & 15) * 8;
    zz8[i] = __builtin_nontemporal_load((const u32x4*)(p.za + (tokb + P0 + w * 32 + row) * AW + h * HD + d8));
  }
  __builtin_amdgcn_sched_barrier(0);
  const float inv = 1.f / lrun;
  float ss = 0.f;
#pragma unroll
  for (int dt = 0; dt < 4; ++dt)
#pragma unroll
    for (int r = 0; r < 16; ++r) { o[dt][r] *= inv; ss += o[dt][r] * o[dt][r]; }
  ss = xh_sum(ss);
  __syncthreads();
  float* Ot = (float*)smem + w * (32 * 132);
#pragma unroll
  for (int dt = 0; dt < 4; ++dt)
#pragma unroll
    for (int g = 0; g < 4; ++g) {
      f32x4 v = {o[dt][4 * g], o[dt][4 * g + 1], o[dt][4 * g + 2], o[dt][4 * g + 3]};
      *(f32x4*)(Ot + c * 132 + dt * 32 + 8 * g + 4 * hi) = v;
    }
#pragma unroll
  for (int i = 0; i < 8; ++i) {
    const int id = lane + 64 * i, row = id >> 4, d8 = (id & 15) * 8;
    const long tr = tokb + P0 + w * 32 + row;
    const u32x4 zz = zz8[i];
    f32x4 a0 = *(const f32x4*)(Ot + row * 132 + d8), a1 = *(const f32x4*)(Ot + row * 132 + d8 + 4);
    u32x4 ov = {cvtpk(a0[0] * siluf_(bflo(zz[0])), a0[1] * siluf_(bfhi(zz[0]))), cvtpk(a0[2] * siluf_(bflo(zz[1])), a0[3] * siluf_(bfhi(zz[1]))),
                cvtpk(a1[0] * siluf_(bflo(zz[2])), a1[1] * siluf_(bfhi(zz[2]))), cvtpk(a1[2] * siluf_(bflo(zz[3])), a1[3] * siluf_(bfhi(zz[3])))};
    *(u32x4*)(p.mixed + tr * DM + h * HD + d8) = ov;
  }
  if (hi == 0) atomicAdd(p.ssq + tokb + qrow, ss);
}

__device__ void phase_outproj(const Params& p) {
  for (int round = 0; round < 2; ++round) {
    int pm, pn; tile_map(round, 1, pm, pn);
    const int brow = pm * BM, bcol = pn * BM;
    f32x4 acc[2][2][4][2] = {};
    {
      const int t_ = threadIdx.x;
      if (t_ < BM) {
        const float ra = __builtin_amdgcn_rsqf(p.ssq[brow + t_] * (1.f / AW) + EPS), rl = __builtin_amdgcn_rsqf(p.ssq[MTOK + brow + t_] * (1.f / LW) + EPS);
        ((float*)(smem + SHM_BYTES))[t_] = ra * __builtin_amdgcn_rcpf(rl);
      }
    }
    gemm_core<true>(p.mixed, p.WoutT, brow, bcol, acc, p.ssq);
    __syncthreads();
    int tid = threadIdx.x; asm volatile("" : "+v"(tid));
    const int wid = tid >> 6, lane = tid & 63, wr = wid >> 2, wc = wid & 3, fr = lane & 15, fq = lane >> 4;
    const int rg = lane >> 4, l16 = lane & 15;
    float* C32 = (float*)smem;
    f32x4 y[2][4][4];
#define XLOAD(ai) do { _Pragma("unroll") for (int i = 0; i < 4; ++i) { const unsigned grow = brow + (ai) * HALF + i * 32 + wid * 4 + rg; \
      const unsigned xo = grow * DM + bcol + l16 * 4; \
      _Pragma("unroll") for (int k = 0; k < 4; ++k) y[ai][i][k] = __builtin_nontemporal_load((const f32x4*)(p.x + xo + 64 * k)); } } while (0)
#define CSTAGE(ai) do { _Pragma("unroll") for (int bj = 0; bj < 2; ++bj) _Pragma("unroll") for (int m = 0; m < 4; ++m) \
      _Pragma("unroll") for (int n = 0; n < 2; ++n) { \
        const int r = wr * 64 + m * 16 + fr, c = bj * 128 + wc * 32 + n * 16 + fq * 4; \
        *(f32x4*)(C32 + r * 256 + (c ^ (fr << 2))) = acc[ai][bj][m][n]; } } while (0)
#define YCOMB(ai) do { float sq_[4]; _Pragma("unroll") for (int i = 0; i < 4; ++i) sq_[i] = p.ssq[MTOK + brow + (ai) * HALF + i * 32 + wid * 4 + rg]; \
    _Pragma("unroll") for (int i = 0; i < 4; ++i) { const int row = i * 32 + wid * 4 + rg; \
      const float rl_ = __builtin_amdgcn_rsqf(sq_[i] * (1.f / LW) + EPS); float sq = 0.f; \
      _Pragma("unroll") for (int k = 0; k < 4; ++k) { const int c4 = l16 * 4 + 64 * k; \
        f32x4 a = *(const f32x4*)(C32 + row * 256 + (c4 ^ ((((wid & 3) << 2) + rg) << 2))); f32x4 yv = y[ai][i][k]; \
        yv[0] += rl_ * a[0]; yv[1] += rl_ * a[1]; yv[2] += rl_ * a[2]; yv[3] += rl_ * a[3]; y[ai][i][k] = yv; \
        sq += yv[0] * yv[0] + yv[1] * yv[1] + yv[2] * yv[2] + yv[3] * yv[3]; } \
      sq += __shfl_xor(sq, 1); sq += __shfl_xor(sq, 2); sq += __shfl_xor(sq, 4); sq += __shfl_xor(sq, 8); sq_[i] = sq; } \
      if (l16 == 0) { _Pragma("unroll") for (int i = 0; i < 4; ++i) atomicAdd(p.ssq + 2 * MTOK + brow + (ai) * HALF + i * 32 + wid * 4 + rg, sq_[i]); } } while (0)
    CSTAGE(0);
    XLOAD(0);
    __syncthreads();
    XLOAD(1);
    YCOMB(0);
    __syncthreads();
    CSTAGE(1);
    __syncthreads();
    YCOMB(1);
#undef XLOAD
#undef CSTAGE
#undef YCOMB
    f32x4 g[4];
#pragma unroll
    for (int k = 0; k < 4; ++k) g[k] = *(const f32x4*)(p.fg + bcol + l16 * 4 + 64 * k);
    unsigned* cnt = (unsigned*)p.ssq + 3 * MTOK + 16 + pm;
    asm volatile("s_waitcnt vmcnt(0)" ::: "memory");
    __syncthreads();
    if (tid == 0) {
      __threadfence();
      atomicAdd(cnt, 1u);
      while (__hip_atomic_load(cnt, __ATOMIC_ACQUIRE, __HIP_MEMORY_SCOPE_AGENT) < 8u) __builtin_amdgcn_s_sleep(2);
    }
    __syncthreads();
    float sy[2][4];
#pragma unroll
    for (int ai = 0; ai < 2; ++ai)
#pragma unroll
      for (int i = 0; i < 4; ++i)
        sy[ai][i] = __hip_atomic_load(p.ssq + 2 * MTOK + brow + ai * HALF + i * 32 + wid * 4 + rg, __ATOMIC_RELAXED, __HIP_MEMORY_SCOPE_AGENT);
#pragma unroll
    for (int ai = 0; ai < 2; ++ai)
#pragma unroll
      for (int i = 0; i < 4; ++i) {
        const unsigned xo = (unsigned)(brow + ai * HALF + i * 32 + wid * 4 + rg) * DM + bcol + l16 * 4;
        const float rs = __builtin_amdgcn_rsqf(sy[ai][i] * (1.f / DM) + EPS);
#pragma unroll
        for (int k = 0; k < 4; ++k) {
          f32x4 yv = y[ai][i][k];
          f32x4 o = {yv[0] * rs * g[k][0], yv[1] * rs * g[k][1], yv[2] * rs * g[k][2], yv[3] * rs * g[k][3]};
          __builtin_nontemporal_store(o, (f32x4*)(p.out + xo + 64 * k));
        }
      }
    __syncthreads();
  }
}

#define XB_TMO      128
#define XB_XCNT(j)  (256  + 64 * (j))
#define XB_XSUB(j)  (1280 + 64 * (j))
#define XB_XGEN(j)  (2304 + 64 * (j))
#define XB_TOP      3328
#define XB_TOPGEN   3392
#define XCD_BAR_WORDS 3456
#define XB_SPIN_CAP (1u << 18)
#define LAS __attribute__((address_space(3)))

__device__ __forceinline__ unsigned xb_ld(unsigned* p)              { return __hip_atomic_load(p, __ATOMIC_RELAXED, __HIP_MEMORY_SCOPE_AGENT); }
__device__ __forceinline__ unsigned xb_add(unsigned* p, unsigned v) { return __hip_atomic_fetch_add(p, v, __ATOMIC_RELAXED, __HIP_MEMORY_SCOPE_AGENT); }
__device__ __forceinline__ unsigned xb_xcc_id() { return (unsigned)__builtin_amdgcn_s_getreg((3 << 11) | 20) & 0xFu; }
#define XB_SPIN(cond, bar) do { unsigned _sp = 0; while (cond) { __builtin_amdgcn_s_sleep(1); \
    if ((++_sp & 255u) == 0u) { if (xb_ld(&(bar)[XB_TMO])) break; if (_sp > XB_SPIN_CAP) { atomicAdd(&(bar)[XB_TMO], 1u); break; } } } } while (0)

struct XcdBarrier {
    unsigned* bar; unsigned x;
    volatile LAS unsigned* st;
};

__device__ __forceinline__ XcdBarrier xcd_barrier_post(unsigned* bar, volatile LAS unsigned* st) {
    XcdBarrier b; b.bar = bar; b.x = xb_xcc_id(); b.st = st;
    if (threadIdx.x == 0) (void)xb_add(&bar[XB_XCNT(b.x)], 1u);
    return b;
}
__device__ __forceinline__ void xcd_barrier_complete(unsigned* bar, unsigned x, unsigned& nloc, unsigned& nx) {
    const unsigned G = gridDim.x * gridDim.y * gridDim.z;
    unsigned sum, cnt, mine, sp = 0u;
    for (;;) {
        sum = 0u; cnt = 0u; mine = 0u;
#pragma unroll
        for (unsigned j = 0; j < 16; ++j) { const unsigned c = xb_ld(&bar[XB_XCNT(j)]); sum += c; cnt += (c > 0u) ? 1u : 0u; mine = (j == x) ? c : mine; }
        if (sum == G) break;
        __builtin_amdgcn_s_sleep(1);
        if ((++sp & 255u) == 0u) { if (xb_ld(&bar[XB_TMO])) break; if (sp > XB_SPIN_CAP) { atomicAdd(&bar[XB_TMO], 1u); break; } }
    }
    nloc = mine > 0u ? mine : 1u; nx = cnt > 0u ? cnt : 1u;
}

__device__ __forceinline__ void xcd_barrier(const XcdBarrier& b) {
    asm volatile("s_waitcnt vmcnt(0)" ::: "memory");
    __syncthreads();
    if (threadIdx.x == 0) {
        unsigned* bar = b.bar;
        __builtin_amdgcn_s_waitcnt(0);
        unsigned nloc = b.st[0], nx = b.st[1];
        if (nloc == 0u) { xcd_barrier_complete(bar, b.x, nloc, nx); b.st[0] = nloc; b.st[1] = nx; }
        const unsigned old = xb_add(&bar[XB_XSUB(b.x)], 1u);
        const unsigned gen = old / nloc;
        if (old + 1u == (gen + 1u) * nloc) {
            __builtin_amdgcn_fence(__ATOMIC_RELEASE, "agent");
            asm volatile("s_waitcnt vmcnt(0)" ::: "memory");
            const unsigned og = xb_add(&bar[XB_TOP], 1u);
            const unsigned tg = og / nx;
            if (og + 1u == (tg + 1u) * nx) xb_add(&bar[XB_TOPGEN], 1u);
            else XB_SPIN(xb_ld(&bar[XB_TOPGEN]) == tg, bar);
            __builtin_amdgcn_fence(__ATOMIC_ACQUIRE, "agent");
            xb_add(&bar[XB_XGEN(b.x)], 1u);
            asm volatile("s_waitcnt vmcnt(0)" ::: "memory");
        } else {
            XB_SPIN(xb_ld(&bar[XB_XGEN(b.x)]) == gen, bar);
            __builtin_amdgcn_fence(__ATOMIC_ACQUIRE, "agent");
            asm volatile("s_waitcnt vmcnt(0)" ::: "memory");
        }
    }
    __syncthreads();
}


__device__ __forceinline__ void phase_c(const Params& p) {
  if (blockIdx.x < NB * NH) cumsum_item(p, blockIdx.x);
  lru_phase<1>(p);
}
__device__ __forceinline__ void phase_d(const Params& p) {
  lru_carry_block(p);
  lru_phase<2>(p);
  for (int it = blockIdx.x; it < NB * NH * 16; it += gridDim.x) {
    const int b = it >> 7, hr = (it >> 4) & 7, xq = it & 15;
    int h1 = 0, h2 = 0;
#pragma unroll
    for (int h = 0; h < NH; ++h) {
      int rank = 0;
      const float bh_ = p.b_f[h];
#pragma unroll
      for (int g = 0; g < NH; ++g) { const float bg = p.b_f[g]; rank += (bg < bh_ || (bg == bh_ && g < h)) ? 1 : 0; }
      if (rank == hr) h1 = h;
      if (rank == 7 - hr) h2 = h;
    }
    attn_item(p, b, h1, 31 - xq);
    __syncthreads();
    attn_item(p, b, h2, xq);
    __syncthreads();
  }
}

__global__ void __launch_bounds__(NTHR, 2) hymba_fwd(Params p) {
  cg::grid_group grid = cg::this_grid();
  __shared__ uint4 xb_words;
  if (threadIdx.x == 0) xb_words = make_uint4(0u, 0u, 0u, 0u);
  __syncthreads();
#define SEAM() do { XcdBarrier xb_; xb_.bar = p.bar; xb_.x = xb_xcc_id(); xb_.st = (volatile LAS unsigned*)&xb_words; xcd_barrier(xb_); } while (0)
  (void)xcd_barrier_post(p.bar, (volatile LAS unsigned*)&xb_words);
  phase_prep(p);
  if (p.bar == nullptr) grid.sync(); else SEAM();
  phase_inproj(p);
  SEAM();
  phase_c(p);
  SEAM();
  phase_d(p);
  SEAM();
  phase_outproj(p);
#undef SEAM
}

extern "C" void kernel_launch(void* const* d_in, const int* in_sizes, int n_in, void* d_out, int out_size, void* d_ws, size_t ws_size,
                              hipStream_t stream) {
  Params p{};
  p.x = (const float*)d_in[0]; p.norm_g = (const float*)d_in[1]; p.w_in = (const float*)d_in[2]; p.b_f = (const float*)d_in[3];
  p.conv_w = (const float*)d_in[4]; p.conv_b = (const float*)d_in[5]; p.w_rg = (const float*)d_in[6]; p.b_rg = (const float*)d_in[7];
  p.w_ig = (const float*)d_in[8]; p.b_ig = (const float*)d_in[9]; p.lam = (const float*)d_in[10]; p.ag = (const float*)d_in[11];
  p.lg = (const float*)d_in[12]; p.w_out = (const float*)d_in[13]; p.fg = (const float*)d_in[14];
  p.out = (float*)d_out;
  char* ws = (char*)d_ws; size_t off = 0;
  auto take = [&](size_t bytes) { char* r = ws + off; off += (bytes + 255) & ~(size_t)255; return r; };
  p.hb = (u16*)take((size_t)MTOK * DM * 2);
  p.WinT = (u16*)take((size_t)NP * KD * 2);
  p.WoutT = (u16*)take((size_t)DM * KD * 2);
  p.WgT = (u16*)take((size_t)16 * 128 * 128 * 2);
  p.qb = (u16*)take((size_t)MTOK * AW * 2);
  p.kb = (u16*)take((size_t)MTOK * AW * 2);
  p.vT = (u16*)take((size_t)MTOK * AW * 2);
  p.za = (u16*)take((size_t)MTOK * AW * 2);
  p.xl = (u16*)take((size_t)MTOK * LW * 2);
  p.zl = (u16*)take((size_t)MTOK * LW * 2);
  p.mixed = (u16*)take((size_t)MTOK * DM * 2);
  p.logf = (float*)take((size_t)NB * NH * SEQ * 4);
  p.c2 = (float*)take((size_t)NB * NH * SEQ * 4);
  p.ssq = (float*)take((size_t)(3 * MTOK + 16 + 64) * 4);
  p.lruA = (float*)take((size_t)NB * NCHUNK * LW * 4);
  p.lruH = (float*)take((size_t)NB * NCHUNK * LW * 4);
  p.bar = (unsigned*)take((size_t)4096 * 4);

  static int grid_blocks = 0;
  if (!grid_blocks) {
    hipFuncSetAttribute((const void*)hymba_fwd, hipFuncAttributeMaxDynamicSharedMemorySize, SHM_TOTAL);
    int dev = 0, cus = 0, per_cu = 0;
    hipGetDevice(&dev);
    hipDeviceGetAttribute(&cus, hipDeviceAttributeMultiprocessorCount, dev);
    hipOccupancyMaxActiveBlocksPerMultiprocessor(&per_cu, hymba_fwd, NTHR, SHM_TOTAL);
    if (per_cu < 1) per_cu = 1;
    grid_blocks = 256;
    (void)per_cu; (void)cus;
  }
  hipMemsetAsync(p.bar, 0, (size_t)4096 * 4, stream);
  void* args[] = {&p};
  hipError_t e = hipLaunchCooperativeKernel((const void*)hymba_fwd, dim3(grid_blocks), dim3(NTHR), args, SHM_TOTAL, stream);
  if (e != hipSuccess) fprintf(stderr, "cooperative launch failed: %s (grid %d)\n", hipGetErrorString(e), grid_blocks);
}
```
